# Optimizing an MI355X kernel written in HIP

```python
import math
import jax, jax.numpy as jnp
from jax import lax
import numpy as np

D_MODEL = 1024
BATCH = 8
SEQ = 2048
DEPTH = 2

N_MIXERS = 2
N_SSD_LAYERS = (DEPTH + 1) // 2
N_CONV_LAYERS = DEPTH // 2
NORM_EPS = 1e-5
ADA_MODS = 6

SSD_EXPAND = 2
SSD_D_INNER = SSD_EXPAND * D_MODEL
SSD_HEAD_DIM = 64
SSD_N_HEADS = SSD_D_INNER // SSD_HEAD_DIM
SSD_N_GROUPS = 4
SSD_HEADS_PER_GROUP = SSD_N_HEADS // SSD_N_GROUPS
SSD_D_STATE = 128
SSD_CONV_K = 4
SSD_CHUNK = 128
SSD_CONV_DIM = SSD_D_INNER + 2 * SSD_N_GROUPS * SSD_D_STATE
SSD_IN_DIM = SSD_D_INNER + SSD_CONV_DIM + SSD_N_HEADS
DT_MIN = 1e-3
DT_MAX = 1e-1

SC_WIDTH = D_MODEL
SC_CONV_K = 3

D_FF = 4 * D_MODEL

kernel_name = "hybrid_ssd_shortconv_adaln_trunk"


def rmsnorm(x, g, eps=NORM_EPS):
    xf = x.astype(jnp.float32)
    y = xf * lax.rsqrt(jnp.mean(xf * xf, axis=-1, keepdims=True) + eps)
    return (y * g.astype(jnp.float32)).astype(x.dtype)


def causal_dwconv(x, w, b=None):
    k, ch = w.shape
    out = lax.conv_general_dilated(
        x, w[:, None, :].astype(x.dtype), window_strides=(1,), padding=[(k - 1, 0)],
        dimension_numbers=("NWC", "WIO", "NWC"), feature_group_count=ch)
    if b is not None:
        out = out + b.astype(x.dtype)
    return out


def ssd_chunked(xs, dt, A, Bm, Cm):
    b, L, g, r, p = xs.shape
    n = Bm.shape[-1]
    nc = L // SSD_CHUNK
    xs = xs.astype(jnp.float32).reshape(b, nc, SSD_CHUNK, g, r, p)
    dt = dt.reshape(b, nc, SSD_CHUNK, g, r)
    Bc = Bm.astype(jnp.float32).reshape(b, nc, SSD_CHUNK, g, n)
    Cc = Cm.astype(jnp.float32).reshape(b, nc, SSD_CHUNK, g, n)
    X = xs * dt[..., None]
    Acs = jnp.cumsum(dt * A, axis=2)

    causal = jnp.tril(jnp.ones((SSD_CHUNK, SSD_CHUNK), dtype=bool))[:, :, None, None]
    seg = Acs[:, :, :, None] - Acs[:, :, None, :]
    Lmat = jnp.exp(jnp.where(causal, seg, -jnp.inf))
    scores = jnp.einsum("bclgn,bcsgn->bclsg", Cc, Bc)
    M = scores[..., None] * Lmat
    y_diag = jnp.einsum("bclsgr,bcsgrp->bclgrp", M, X)

    decay_states = jnp.exp(Acs[:, :, -1:] - Acs)
    states = jnp.einsum("bcsgn,bcsgrp->bcgrpn", Bc, X * decay_states[..., None])

    chunk_decay = jnp.exp(Acs[:, :, -1])

    def step(carry, inp):
        st, dec = inp
        return carry * dec[..., None, None] + st, carry

    init = jnp.zeros((b, g, r, p, n), dtype=states.dtype)
    _, prev = lax.scan(step, init, (jnp.moveaxis(states, 1, 0), jnp.moveaxis(chunk_decay, 1, 0)))
    prev = jnp.moveaxis(prev, 0, 1)

    y_off = jnp.einsum("bclgn,bcgrpn->bclgrp", Cc, prev) * jnp.exp(Acs)[..., None]
    return (y_diag + y_off).reshape(b, L, g, r, p)


def ssd_mixer(h, in_w, conv_w, conv_b, dt_bias, A_log, D_skip, norm_w, out_w):
    b, L, _ = h.shape
    G, R, P, N = SSD_N_GROUPS, SSD_HEADS_PER_GROUP, SSD_HEAD_DIM, SSD_D_STATE
    zxbcdt = h @ in_w
    z = zxbcdt[..., :SSD_D_INNER]
    xBC = zxbcdt[..., SSD_D_INNER:SSD_D_INNER + SSD_CONV_DIM]
    dt_raw = zxbcdt[..., SSD_D_INNER + SSD_CONV_DIM:]
    xBC = jax.nn.silu(causal_dwconv(xBC, conv_w, conv_b))
    xs = xBC[..., :SSD_D_INNER].reshape(b, L, G, R, P)
    Bm = xBC[..., SSD_D_INNER:SSD_D_INNER + G * N].reshape(b, L, G, N)
    Cm = xBC[..., SSD_D_INNER + G * N:].reshape(b, L, G, N)
    dt = jax.nn.softplus(dt_raw.astype(jnp.float32) + dt_bias.astype(jnp.float32)).reshape(b, L, G, R)
    A = -jnp.exp(A_log.astype(jnp.float32)).reshape(G, R)
    y = ssd_chunked(xs, dt, A, Bm, Cm)
    y = y + D_skip.astype(jnp.float32).reshape(G, R, 1) * xs.astype(jnp.float32)
    yg = y.reshape(b, L, SSD_D_INNER) * jax.nn.silu(z.astype(jnp.float32))
    yg = yg.reshape(b, L, G, SSD_D_INNER // G)
    yg = yg * lax.rsqrt(jnp.mean(yg * yg, axis=-1, keepdims=True) + NORM_EPS)
    yg = yg.reshape(b, L, SSD_D_INNER) * norm_w.astype(jnp.float32)
    return yg.astype(h.dtype) @ out_w


def short_conv_mixer(h, in_w, conv_w, out_w):
    proj = h @ in_w
    Bg, Cg, xv = jnp.split(proj, 3, axis=-1)
    y = Bg * causal_dwconv(Cg * xv, conv_w)
    return y @ out_w


def sqrelu_mlp(h, up_w, down_w):
    a = jax.nn.relu(h @ up_w)
    return (a * a) @ down_w


def setup_inputs(seed: int = 0) -> dict:
    key = jax.random.key(seed)
    ks = jax.random.split(key, 24)
    f32 = jnp.float32
    D = D_MODEL
    nrm = lambda k, shape, s: jax.random.normal(k, shape, f32) * s
    x = jax.random.normal(ks[0], (BATCH, SEQ, D), f32)
    c = jax.random.normal(ks[1], (BATCH, D), f32)
    ada_w = nrm(ks[2], (DEPTH, D, ADA_MODS * D), 0.5 * D ** -0.5)
    ada_b = nrm(ks[3], (DEPTH, ADA_MODS * D), 0.02)
    mix_norm_w = 1.0 + nrm(ks[4], (DEPTH, D), 0.02)
    mlp_norm_w = 1.0 + nrm(ks[5], (DEPTH, D), 0.02)
    mlp_up = nrm(ks[6], (DEPTH, D, D_FF), D ** -0.5)
    mlp_down = nrm(ks[7], (DEPTH, D_FF, D), D_FF ** -0.5)
    ssd_in_w = nrm(ks[8], (N_SSD_LAYERS, D, SSD_IN_DIM), D ** -0.5)
    ssd_conv_w = nrm(ks[9], (N_SSD_LAYERS, SSD_CONV_K, SSD_CONV_DIM), SSD_CONV_K ** -0.5)
    ssd_conv_b = nrm(ks[10], (N_SSD_LAYERS, SSD_CONV_DIM), 0.02)
    u = jax.random.uniform(ks[11], (N_SSD_LAYERS, SSD_N_HEADS), f32)
    dt0 = jnp.exp(u * (math.log(DT_MAX) - math.log(DT_MIN)) + math.log(DT_MIN))
    ssd_dt_bias = dt0 + jnp.log(-jnp.expm1(-dt0))
    ssd_A_log = jnp.log(jax.random.uniform(ks[12], (N_SSD_LAYERS, SSD_N_HEADS), f32, 1.0, 16.0))
    ssd_D = 1.0 + nrm(ks[13], (N_SSD_LAYERS, SSD_N_HEADS), 0.02)
    ssd_norm_w = 1.0 + nrm(ks[14], (N_SSD_LAYERS, SSD_D_INNER), 0.02)
    ssd_out_w = nrm(ks[15], (N_SSD_LAYERS, SSD_D_INNER, D), SSD_D_INNER ** -0.5)
    sc_in_w = nrm(ks[16], (N_CONV_LAYERS, D, 3 * SC_WIDTH), D ** -0.5)
    sc_conv_w = nrm(ks[17], (N_CONV_LAYERS, SC_CONV_K, SC_WIDTH), SC_CONV_K ** -0.5)
    sc_out_w = nrm(ks[18], (N_CONV_LAYERS, SC_WIDTH, D), SC_WIDTH ** -0.5)
    final_norm_w = 1.0 + nrm(ks[19], (D,), 0.02)
    return {"x": x, "c": c, "ada_w": ada_w, "ada_b": ada_b,
            "mix_norm_w": mix_norm_w, "mlp_norm_w": mlp_norm_w,
            "mlp_up": mlp_up, "mlp_down": mlp_down,
            "ssd_in_w": ssd_in_w, "ssd_conv_w": ssd_conv_w, "ssd_conv_b": ssd_conv_b,
            "ssd_dt_bias": ssd_dt_bias, "ssd_A_log": ssd_A_log, "ssd_D": ssd_D,
            "ssd_norm_w": ssd_norm_w, "ssd_out_w": ssd_out_w,
            "sc_in_w": sc_in_w, "sc_conv_w": sc_conv_w, "sc_out_w": sc_out_w,
            "final_norm_w": final_norm_w}


def reference(x, c, ada_w, ada_b, mix_norm_w, mlp_norm_w, mlp_up, mlp_down,
              ssd_in_w, ssd_conv_w, ssd_conv_b, ssd_dt_bias, ssd_A_log, ssd_D,
              ssd_norm_w, ssd_out_w, sc_in_w, sc_conv_w, sc_out_w, final_norm_w):
    cond = jax.nn.silu(c.astype(x.dtype))
    for i in range(DEPTH):
        mod = cond @ ada_w[i] + ada_b[i]
        sh_m, sc_m, g_m, sh_f, sc_f, g_f = [m[:, None, :] for m in jnp.split(mod, ADA_MODS, axis=-1)]
        h = rmsnorm(x, mix_norm_w[i]) * (1.0 + sc_m) + sh_m
        j = i // N_MIXERS
        if i % N_MIXERS == 0:
            y = ssd_mixer(h, ssd_in_w[j], ssd_conv_w[j], ssd_conv_b[j], ssd_dt_bias[j],
                          ssd_A_log[j], ssd_D[j], ssd_norm_w[j], ssd_out_w[j])
        else:
            y = short_conv_mixer(h, sc_in_w[j], sc_conv_w[j], sc_out_w[j])
        x = x + g_m * y
        h = rmsnorm(x, mlp_norm_w[i]) * (1.0 + sc_f) + sh_f
        x = x + g_f * sqrelu_mlp(h, mlp_up[i], mlp_down[i])
    return rmsnorm(x, final_norm_w)
```

```cpp
#include <hip/hip_runtime.h>
#include <hip/hip_cooperative_groups.h>
#include <cstdio>
#include <cstdint>
namespace cg = cooperative_groups;
namespace pg8 {
#define PG8_LAS __attribute__((address_space(3)))
typedef unsigned short bf16_t;
typedef short bf16x8 __attribute__((ext_vector_type(8)));
typedef float f32x4 __attribute__((ext_vector_type(4)));
typedef unsigned u32x4 __attribute__((ext_vector_type(4)));
constexpr int BM = 256, BK = 64, HALF = 128, HTB = HALF * BK * 2  , STAGE_BYTES = 8 * HTB, NXCD = 8, WGM = 8;

__host__ __device__ __forceinline__ int lds_byte(int r, int c) { const int st = (r >> 4) * 2 + (c >> 5), rr = r & 15, cc = c & 31, ob = rr * 64 + cc * 2; return st * 1024 + (ob ^ (((ob >> 9) & 1) << 5)); }
__host__ __device__ __forceinline__ void stage_rc(int b, int& R, int& C) { const int st = b / 1024, sb = b % 1024, swz = sb ^ (((sb >> 9) & 1) << 5); R = (st >> 1) * 16 + swz / 64; C = (st & 1) * 32 + (swz % 64) / 2; }
__host__ __device__ __forceinline__ int perm32(int rho) { const int n = rho >> 4, i = rho & 15; return 8 * (i >> 2) + 4 * n + (i & 3); }

struct Unit { int pm, pn; };
struct Gemm { const bf16_t* A; const bf16_t* Bt; int M, N, K; };

struct StaticOrder {
    int nM, nN, nwg, G, c;
    __host__ __device__ void init(int M, int N, int G_, int c_) { nM = M / BM; nN = N / BM; nwg = nM * nN; G = G_; c = c_; }
    __host__ __device__ bool next(int i, Unit& u) const {
        const long L = (long)i * G + c; if (L >= nwg) return false;
        int wgid = (int)L; { const int q = nwg / NXCD, r = nwg % NXCD, xcd = wgid % NXCD, off = wgid / NXCD; wgid = (xcd < r ? xcd * (q + 1) : r * (q + 1) + (xcd - r) * q) + off; }
        const int nig = WGM * nN, gid = wgid / nig, fm = gid * WGM, gsz = (nM - fm) < WGM ? (nM - fm) : WGM;
        u.pm = fm + ((wgid % nig) % gsz); u.pn = (wgid % nig) / gsz; return true;
    }
    __device__ __forceinline__ void a_ready(const Unit&) const {}
    __device__ __forceinline__ void done(const Unit&) const {}
};
__device__ __forceinline__ unsigned cvt_pk_bf16(float lo, float hi) { unsigned r; asm volatile("v_cvt_pk_bf16_f32 %0, %1, %2" : "=v"(r) : "v"(lo), "v"(hi)); return r; }
typedef float f32x2 __attribute__((ext_vector_type(2)));
__device__ __forceinline__ unsigned pk2bf(float lo, float hi) { unsigned r; asm("v_cvt_pk_bf16_f32 %0, %1, %2" : "=v"(r) : "v"(lo), "v"(hi)); return r; }
template <int ACT  > struct EpiBf16S {
    static constexpr bool PERM = true, AFTER_DRAIN = false;
    bf16_t* O0; int ld0; bf16_t* O1; int ld1; int csplit;
    __device__ __forceinline__ void operator()(const f32x4 (&acc)[2][2][4][2], const Unit& u, int wr, int wc, int fr, int fq) const {
        const int row0 = u.pm * BM + wr * 64 + fr; int colt = u.pn * BM; bf16_t* base = O0; int ldc = ld0;
        if (colt >= csplit) { base = O1; ldc = ld1; colt -= csplit; }
        const int col0 = colt + wc * 32 + 8 * fq;
#pragma unroll
        for (int ai = 0; ai < 2; ++ai)
#pragma unroll
            for (int m = 0; m < 4; ++m) { bf16_t* rowp = base + (size_t)(row0 + ai * HALF + m * 16) * ldc + col0;
#pragma unroll
                for (int bj = 0; bj < 2; ++bj) { f32x4 v0 = acc[ai][bj][m][0], v1 = acc[ai][bj][m][1];
                    if (ACT == 2) {
#pragma unroll
                        for (int e = 0; e < 4; ++e) { float a0 = fmaxf(v0[e], 0.f), a1 = fmaxf(v1[e], 0.f); v0[e] = a0 * a0; v1[e] = a1 * a1; } }
                    u32x4 w; w.x = pk2bf(v0[0], v0[1]); w.y = pk2bf(v0[2], v0[3]); w.z = pk2bf(v1[0], v1[1]); w.w = pk2bf(v1[2], v1[3]);
                    *(u32x4*)(rowp + bj * HALF) = w; } }
    }
};
struct EpiRes {
    static constexpr bool PERM = false, AFTER_DRAIN = false;
    const float* base; float* out; const float* gate;
    __device__ __forceinline__ void operator()(const f32x4 (&acc)[2][2][4][2], const Unit& u, int wr, int wc, int fr, int fq) const {
        const int b = (u.pm * BM) >> 11; const float* gp = gate + (size_t)b * 6144;
        const int col0 = u.pn * BM + wc * 32 + 4 * fq;
        f32x4 gv[2][2];
#pragma unroll
        for (int bj = 0; bj < 2; ++bj)
#pragma unroll
            for (int n = 0; n < 2; ++n) gv[bj][n] = *(const f32x4*)(gp + col0 + bj * HALF + n * 16);
#pragma unroll
        for (int ai = 0; ai < 2; ++ai)
#pragma unroll
            for (int m = 0; m < 4; ++m) { const size_t off = (size_t)(u.pm * BM + ai * HALF + wr * 64 + m * 16 + fr) * 1024 + col0;
#pragma unroll
                for (int bj = 0; bj < 2; ++bj)
#pragma unroll
                    for (int n = 0; n < 2; ++n) { const f32x4 bs = *(const f32x4*)(base + off + bj * HALF + n * 16);
                        *(f32x4*)(out + off + bj * HALF + n * 16) = bs + gv[bj][n] * acc[ai][bj][m][n]; }
                asm volatile("" ::: "memory"); }
    }
};

template <class Epi, class Sched, bool ALIGN_EPI = false, bool SP2 = false>
__device__ __forceinline__ void gemm_phase(PG8_LAS unsigned char* lds, const Gemm g, const Sched& S, const Epi& E) {
    const int tid = threadIdx.x, wid = __builtin_amdgcn_readfirstlane(tid >> 6), lane = tid & 63, wr = wid >> 2, wc = wid & 3, fr = lane & 15, fq = lane >> 4;
    const int K = g.K, nt = K / BK;
    unsigned voffA[2], voffB[2];
#pragma unroll
    for (int i = 0; i < 2; ++i) { int R, C; stage_rc(tid * 16 + i * 8192, R, C); const int Rb = Epi::PERM ? ((R & ~31) + perm32(R & 31)) : R;
        voffA[i] = (unsigned)(R * K + C) * 2u; voffB[i] = (unsigned)(Rb * K + C) * 2u; }
    const size_t kstep = (size_t)(BK * 2);
    const size_t hstep = (size_t)HALF * K * 2;
    const size_t tstep = 2 * hstep;
    const unsigned ldsw = (unsigned)wid * 1024u;
    const int aoff = lds_byte(wr * 64 + fr, fq * 8), boff = lds_byte(wc * 32 + fr, fq * 8);
#define PG8_SA(b, h) (((b) * 2 + (h)) * HTB)
#define PG8_SB(b, h) ((4 + (b) * 2 + (h)) * HTB)
#define PG8_STAGE(bufoff, gbase, voff) do { _Pragma("unroll") for (int _i = 0; _i < 2; ++_i) \
        __builtin_amdgcn_global_load_lds((const unsigned*)((const char*)(gbase) + (voff)[_i]), (PG8_LAS unsigned*)(lds + (bufoff) + ldsw + _i * 8192), 16, 0, 0); } while (0)
#define PG8_LDA(dst, b, h) do { _Pragma("unroll") for (int m = 0; m < 4; ++m) _Pragma("unroll") for (int k = 0; k < 2; ++k) dst[m][k] = *(const PG8_LAS bf16x8*)(lds + PG8_SA(b, h) + aoff + m * 2048 + k * 1024); } while (0)
#define PG8_LDB(dst, b, h) do { _Pragma("unroll") for (int n = 0; n < 2; ++n) _Pragma("unroll") for (int k = 0; k < 2; ++k) dst[n][k] = *(const PG8_LAS bf16x8*)(lds + PG8_SB(b, h) + boff + n * 2048 + k * 1024); } while (0)
#define PG8_MMA(ai, bj, At, Bt) do { __builtin_amdgcn_s_setprio(1); _Pragma("unroll") for (int m = 0; m < 4; ++m) _Pragma("unroll") for (int n = 0; n < 2; ++n) _Pragma("unroll") for (int k = 0; k < 2; ++k) \
        acc[ai][bj][m][n] = __builtin_amdgcn_mfma_f32_16x16x32_bf16(Bt[n][k], At[m][k], acc[ai][bj][m][n], 0, 0, 0); __builtin_amdgcn_s_setprio(0); } while (0)
#define PG8_WAIT_V(n) asm volatile("s_waitcnt vmcnt(" #n ")" ::: "memory")
#define PG8_WAIT_L(n) asm volatile("s_waitcnt lgkmcnt(" #n ")" ::: "memory")
#define PG8_BAR __builtin_amdgcn_s_barrier()
#define PG8_SCHED __builtin_amdgcn_sched_barrier(0)
    Unit cur, nxt; int ui = 0;
    if (!S.next(0, cur)) return;
    f32x4 acc[2][2][4][2];
#pragma unroll
    for (int a = 0; a < 2; ++a)
#pragma unroll
        for (int b = 0; b < 2; ++b)
#pragma unroll
            for (int m = 0; m < 4; ++m)
#pragma unroll
                for (int n = 0; n < 2; ++n) acc[a][b][m][n] = (f32x4){0.f, 0.f, 0.f, 0.f};
    bf16x8 At[4][2], B0[2][2], B1[2][2];
    const char* cA = (const char*)g.A + (size_t)cur.pm * tstep; const char* cB = (const char*)g.Bt + (size_t)cur.pn * tstep;
    S.a_ready(cur);
    if constexpr (SP2) {
        PG8_STAGE(PG8_SB(0, 0), cB, voffB); PG8_STAGE(PG8_SB(0, 1), cB + hstep, voffB); PG8_STAGE(PG8_SA(0, 0), cA, voffA); PG8_STAGE(PG8_SA(0, 1), cA + hstep, voffA);
        if (wr == 1) PG8_BAR;
        PG8_WAIT_V(2); PG8_BAR;
        PG8_STAGE(PG8_SB(1, 0), cB + kstep, voffB); PG8_STAGE(PG8_SA(1, 0), cA + kstep, voffA); PG8_STAGE(PG8_SB(1, 1), cB + hstep + kstep, voffB);
        PG8_WAIT_V(6); PG8_BAR;
    } else {
        PG8_STAGE(PG8_SB(0, 0), cB, voffB); PG8_STAGE(PG8_SA(0, 0), cA, voffA); PG8_STAGE(PG8_SB(0, 1), cB + hstep, voffB); PG8_STAGE(PG8_SA(0, 1), cA + hstep, voffA);
        if (wr == 1) PG8_BAR;
        PG8_WAIT_V(4); PG8_BAR;
        PG8_STAGE(PG8_SB(1, 0), cB + kstep, voffB); PG8_STAGE(PG8_SA(1, 0), cA + kstep, voffA); PG8_STAGE(PG8_SB(1, 1), cB + hstep + kstep, voffB);
        PG8_WAIT_V(6); PG8_BAR;
    }
    for (;;) {
        const bool has_next = S.next(ui + 1, nxt);
        const char* nA = has_next ? (const char*)g.A + (size_t)nxt.pm * tstep : cA; const char* nB = has_next ? (const char*)g.Bt + (size_t)nxt.pn * tstep : cB;
        for (int t = 0; t < nt; t += 2) {
            const bool last = (t == nt - 2);
            const char* a1 = cA + (size_t)(t + 1) * kstep;
            const char* a2 = last ? nA : cA + (size_t)(t + 2) * kstep; const char* b2 = last ? nB : cB + (size_t)(t + 2) * kstep;
            const char* a3 = a2 + kstep; const char* b3 = b2 + kstep;
            if (last && has_next) S.a_ready(nxt);
            if constexpr (SP2) {
            PG8_LDB(B0, 0, 0); PG8_LDB(B1, 0, 1); PG8_SCHED; PG8_LDA(At, 0, 0); PG8_STAGE(PG8_SA(1, 1), a1 + hstep, voffA);
            PG8_WAIT_V(8); PG8_WAIT_L(0); PG8_BAR; PG8_MMA(0, 0, At, B0); PG8_MMA(0, 1, At, B1); PG8_BAR; PG8_SCHED;
            PG8_LDA(At, 0, 1); PG8_STAGE(PG8_SB(0, 0), b2, voffB); PG8_STAGE(PG8_SB(0, 1), b2 + hstep, voffB); PG8_STAGE(PG8_SA(0, 0), a2, voffA);
            PG8_WAIT_V(8); PG8_WAIT_L(0); PG8_BAR; PG8_MMA(1, 0, At, B0); PG8_MMA(1, 1, At, B1); PG8_BAR; PG8_SCHED;
            PG8_LDB(B0, 1, 0); PG8_LDB(B1, 1, 1); PG8_SCHED; PG8_LDA(At, 1, 0); PG8_STAGE(PG8_SA(0, 1), a2 + hstep, voffA);
            PG8_WAIT_V(8); PG8_WAIT_L(0); PG8_BAR; PG8_MMA(0, 0, At, B0); PG8_MMA(0, 1, At, B1); PG8_BAR; PG8_SCHED;
            PG8_LDA(At, 1, 1); PG8_STAGE(PG8_SB(1, 0), b3, voffB); PG8_STAGE(PG8_SB(1, 1), b3 + hstep, voffB); PG8_STAGE(PG8_SA(1, 0), a3, voffA);
            PG8_WAIT_V(8); PG8_WAIT_L(0); PG8_BAR; PG8_MMA(1, 0, At, B0); PG8_MMA(1, 1, At, B1); PG8_BAR; PG8_SCHED;
            } else {
            PG8_LDB(B0, 0, 0); PG8_SCHED; PG8_LDA(At, 0, 0); PG8_STAGE(PG8_SA(1, 1), a1 + hstep, voffA);
            PG8_WAIT_L(8); PG8_BAR; PG8_WAIT_L(0); PG8_MMA(0, 0, At, B0); PG8_BAR; PG8_SCHED;
            PG8_LDB(B1, 0, 1); PG8_STAGE(PG8_SB(0, 0), b2, voffB);
            PG8_BAR; PG8_WAIT_L(0); PG8_MMA(0, 1, At, B1); PG8_BAR;
            PG8_LDA(At, 0, 1); PG8_STAGE(PG8_SA(0, 0), a2, voffA);
            PG8_BAR; PG8_WAIT_L(0); PG8_MMA(1, 0, At, B0); PG8_BAR; PG8_SCHED;
            PG8_STAGE(PG8_SB(0, 1), b2 + hstep, voffB);
            PG8_WAIT_V(6); PG8_BAR; PG8_MMA(1, 1, At, B1); PG8_BAR;
            PG8_LDB(B0, 1, 0); PG8_SCHED; PG8_LDA(At, 1, 0); PG8_STAGE(PG8_SA(0, 1), a2 + hstep, voffA);
            PG8_WAIT_L(8); PG8_BAR; PG8_WAIT_L(0); PG8_MMA(0, 0, At, B0); PG8_BAR; PG8_SCHED;
            PG8_LDB(B1, 1, 1); PG8_STAGE(PG8_SB(1, 0), b3, voffB);
            PG8_BAR; PG8_WAIT_L(0); PG8_MMA(0, 1, At, B1); PG8_BAR;
            PG8_LDA(At, 1, 1); PG8_STAGE(PG8_SA(1, 0), a3, voffA);
            PG8_BAR; PG8_WAIT_L(0); PG8_MMA(1, 0, At, B0); PG8_BAR; PG8_SCHED;
            PG8_STAGE(PG8_SB(1, 1), b3 + hstep, voffB);
            PG8_WAIT_V(6); PG8_BAR; PG8_MMA(1, 1, At, B1); PG8_BAR;
            }
        }
        if constexpr (ALIGN_EPI) { if (wr == 0) PG8_BAR; }
        if constexpr (!Epi::AFTER_DRAIN) { E(acc, cur, wr, wc, fr, fq); S.done(cur); }
        if (!has_next) break;
#pragma unroll
        for (int a = 0; a < 2; ++a)
#pragma unroll
            for (int b = 0; b < 2; ++b)
#pragma unroll
                for (int m = 0; m < 4; ++m)
#pragma unroll
                    for (int n = 0; n < 2; ++n) acc[a][b][m][n] = (f32x4){0.f, 0.f, 0.f, 0.f};
        cur = nxt; cA = nA; cB = nB; ++ui;
        if constexpr (ALIGN_EPI) { if (wr == 1) PG8_BAR; }
    }
    PG8_WAIT_V(0);
    if constexpr (!ALIGN_EPI) { if (wr == 0) PG8_BAR; }
    PG8_BAR;
    if constexpr (Epi::AFTER_DRAIN) { E.fused(acc, cur, wr, wc, fr, fq, lds, wid, lane); S.done(cur); }
#undef PG8_SA
#undef PG8_SB
#undef PG8_STAGE
#undef PG8_LDA
#undef PG8_LDB
#undef PG8_MMA
#undef PG8_WAIT_V
#undef PG8_WAIT_L
#undef PG8_BAR
#undef PG8_SCHED
}
}
constexpr int SEQ = 2048, BATCH = 8, M = BATCH * SEQ, D = 1024, DFF = 4096, DIN = 2048, NCV = 3072, NH = 32, NIN = 5152, MODW = 6144;
constexpr float EPS = 1e-5f;
constexpr size_t MiB = 1u << 20;
constexpr size_t WS_MODP = 1 * MiB;
constexpr size_t WS_MOD = 2 * MiB + 512 * 1024;
constexpr size_t WS_WIN = 3 * MiB, WS_WOUT = 14 * MiB, WS_WUP0 = 18 * MiB, WS_WUP1 = 26 * MiB, WS_WDN0 = 34 * MiB, WS_WDN1 = 42 * MiB, WS_WSCIN = 50 * MiB, WS_WSCOUT = 56 * MiB;
constexpr size_t WS_DT = 58 * MiB, WS_SS = 60 * MiB, WS_H = 62 * MiB, WS_Z = 94 * MiB, WS_XBC = 158 * MiB, WS_END = 254 * MiB;
constexpr size_t WS_ACT = WS_Z, WS_PROJ = WS_Z, WS_YSC = WS_Z + 96 * MiB;
constexpr int LDS_BYTES = 147456;

#define LAS __attribute__((address_space(3)))
typedef unsigned short bf16;
typedef unsigned u32x4 __attribute__((ext_vector_type(4)));
typedef unsigned u32x2 __attribute__((ext_vector_type(2)));
typedef float f32x4 __attribute__((ext_vector_type(4)));
typedef short bf16x8 __attribute__((ext_vector_type(8)));

__device__ __forceinline__ unsigned pk2(float lo, float hi) { unsigned r; asm("v_cvt_pk_bf16_f32 %0, %1, %2" : "=v"(r) : "v"(lo), "v"(hi)); return r; }
__device__ __forceinline__ float bflo(unsigned w) { return __uint_as_float(w << 16); }
__device__ __forceinline__ float bfhi(unsigned w) { return __uint_as_float(w & 0xffff0000u); }
__device__ __forceinline__ float bf1(bf16 v) { return __uint_as_float(((unsigned)v) << 16); }
__device__ __forceinline__ float fexp(float x) { return __builtin_amdgcn_exp2f(x * 1.4426950408889634f); }
__device__ __forceinline__ float silu_f(float v) { return v * __builtin_amdgcn_rcpf(1.0f + fexp(-v)); }
__device__ __forceinline__ float wave_sum(float v) {
#pragma unroll
    for (int o = 1; o < 64; o <<= 1) v += __shfl_xor(v, o);
    return v;
}
#define LDS_WAIT() asm volatile("s_waitcnt lgkmcnt(0)" ::: "memory")

struct Args { const float* in[20]; float* out; unsigned char* ws; };
enum { I_X = 0, I_C, I_ADAW, I_ADAB, I_MIXNW, I_MLPNW, I_UP, I_DOWN, I_SSDIN, I_SSDCW, I_SSDCB, I_DTB, I_ALOG, I_DSK, I_SSDNW, I_SSDOUT, I_SCIN, I_SCCW, I_SCOUT, I_FNW };

__device__ __forceinline__ void transpose_item(const float* W, int K, int N, bf16* WT, LAS float* scr, int item, int lane) {
    const int nblk = N / 32, kb = item / nblk, nb = item % nblk, k0 = 64 * kb, n0 = 32 * nb;
#pragma unroll 8
    for (int i = 0; i < 32; ++i) { const int kk = 2 * i + (lane >> 5); scr[kk * 33 + (lane & 31)] = W[(size_t)(k0 + kk) * N + n0 + (lane & 31)]; }
    LDS_WAIT(); asm volatile("" ::: "memory");
    const int c = lane & 7;
#pragma unroll
    for (int j = 0; j < 4; ++j) { const int n = (lane >> 3) + 8 * j; const LAS float* s = scr + (8 * c) * 33 + n;
        u32x4 o; o.x = pk2(s[0 * 33], s[1 * 33]); o.y = pk2(s[2 * 33], s[3 * 33]); o.z = pk2(s[4 * 33], s[5 * 33]); o.w = pk2(s[6 * 33], s[7 * 33]);
        *(u32x4*)(WT + (size_t)(n0 + n) * K + k0 + 8 * c) = o; }
    LDS_WAIT(); asm volatile("" ::: "memory");
}

__device__ __forceinline__ void p0_phase(const Args& a, LAS unsigned char* lds, int bid, int G, int tid, int lane, int wave) {
    unsigned char* ws = a.ws;
    LAS float* cond = (LAS float*)lds;
    LAS float* red = (LAS float*)(lds + 32768);
    const float* cin = a.in[I_C];
    for (int i = tid; i < 8192; i += 512) cond[i] = silu_f(cin[i]);
    __syncthreads();
    float* modp = (float*)(ws + WS_MODP);
    for (int it = bid; it < 768; it += G) {
        const int i = it / 384, r = it % 384, cb = r >> 2, ks = r & 3, n0 = cb * 64, k0 = ks * 256 + wave * 32;
        const float* wp = a.in[I_ADAW] + ((size_t)i * 1024 + k0) * MODW + n0 + lane;
        float acc[8];
#pragma unroll
        for (int b = 0; b < 8; ++b) acc[b] = 0.f;
#pragma unroll 8
        for (int kk = 0; kk < 32; ++kk) { const float wv = wp[(size_t)kk * MODW];
#pragma unroll
            for (int b = 0; b < 8; ++b) acc[b] += cond[b * 1024 + k0 + kk] * wv; }
#pragma unroll
        for (int b = 0; b < 8; ++b) red[(wave * 8 + b) * 64 + lane] = acc[b];
        __syncthreads();
        { const int b = tid >> 6; float s = 0.f;
#pragma unroll
          for (int w = 0; w < 8; ++w) s += red[(w * 8 + b) * 64 + lane];
          modp[(size_t)((ks * 2 + i) * 8 + b) * MODW + n0 + lane] = s; }
        __syncthreads();
    }
    LAS float* scr = (LAS float*)(lds + wave * 16384);
    const int gw = bid * 8 + wave, NGW = G * 8;
    constexpr int I0 = 16 * 161, I1 = 32 * 32, I2 = 16 * 128, I4 = 64 * 32, I6 = 16 * 96, I7 = 16 * 32;
    constexpr int NITEMS = I0 + I1 + 2 * I2 + 2 * I4 + I6 + I7;
    for (int it = gw; it < NITEMS; it += NGW) {
        int r = it;
        if (r < I0) { transpose_item(a.in[I_SSDIN], D, NIN, (bf16*)(ws + WS_WIN), scr, r, lane); continue; } r -= I0;
        if (r < I1) { transpose_item(a.in[I_SSDOUT], DIN, D, (bf16*)(ws + WS_WOUT), scr, r, lane); continue; } r -= I1;
        if (r < I2) { transpose_item(a.in[I_UP], D, DFF, (bf16*)(ws + WS_WUP0), scr, r, lane); continue; } r -= I2;
        if (r < I2) { transpose_item(a.in[I_UP] + (size_t)D * DFF, D, DFF, (bf16*)(ws + WS_WUP1), scr, r, lane); continue; } r -= I2;
        if (r < I4) { transpose_item(a.in[I_DOWN], DFF, D, (bf16*)(ws + WS_WDN0), scr, r, lane); continue; } r -= I4;
        if (r < I4) { transpose_item(a.in[I_DOWN] + (size_t)D * DFF, DFF, D, (bf16*)(ws + WS_WDN1), scr, r, lane); continue; } r -= I4;
        if (r < I6) { transpose_item(a.in[I_SCIN], D, 3 * D, (bf16*)(ws + WS_WSCIN), scr, r, lane); continue; } r -= I6;
        transpose_item(a.in[I_SCOUT], D, D, (bf16*)(ws + WS_WSCOUT), scr, r, lane);
    }
}

template <bool PART>
__device__ __forceinline__ void norm_phase(const Args& a, LAS unsigned char* lds, const float* src, const float* gw, int layer, int off_sh, int off_sc, bf16* dst,
                                           int bid, int G, int tid, int lane, int wave) {
    LAS float* Aw = (LAS float*)lds; LAS float* Sw = (LAS float*)(lds + 4096);
    const float* modp = (const float*)(a.ws + WS_MODP); const float* mod = (const float*)(a.ws + WS_MOD);
    for (int ck = bid; ck < 256; ck += G) {
        const int row0 = ck * 64, b = row0 >> 11;
        __syncthreads();
        for (int k = tid; k < 1024; k += 512) {
            float sc, sh;
            if (PART) { sc = a.in[I_ADAB][layer * MODW + off_sc + k]; sh = a.in[I_ADAB][layer * MODW + off_sh + k];
#pragma unroll
                for (int ks = 0; ks < 4; ++ks) { const float* p = modp + (size_t)((ks * 2 + layer) * 8 + b) * MODW; sc += p[off_sc + k]; sh += p[off_sh + k]; } }
            else { const float* p = mod + (size_t)(layer * 8 + b) * MODW; sc = p[off_sc + k]; sh = p[off_sh + k]; }
            Aw[k] = gw[k] * (1.0f + sc); Sw[k] = sh; }
        __syncthreads();
        for (int rr = wave; rr < 64; rr += 8) {
            const int row = row0 + rr;
            const f32x4* xr = (const f32x4*)(src + (size_t)row * D) + lane;
            f32x4 v[4]; float s = 0.f;
#pragma unroll
            for (int j = 0; j < 4; ++j) { v[j] = xr[64 * j]; s += (v[j].x * v[j].x + v[j].y * v[j].y) + (v[j].z * v[j].z + v[j].w * v[j].w); }
            const float rstd = __builtin_amdgcn_rsqf(wave_sum(s) * (1.f / D) + EPS);
            u32x2* o8 = (u32x2*)(dst + (size_t)row * D) + lane;
#pragma unroll
            for (int j = 0; j < 4; ++j) { const f32x4 aw = *(const LAS f32x4*)(Aw + 4 * lane + 256 * j), sw = *(const LAS f32x4*)(Sw + 4 * lane + 256 * j);
                const f32x4 o = v[j] * rstd * aw + sw; u32x2 w; w.x = pk2(o.x, o.y); w.y = pk2(o.z, o.w); o8[64 * j] = w; }
        }
    }
}
__device__ __forceinline__ void mod_finalize(const Args& a, int bid, int G, int tid) {
    const float* modp = (const float*)(a.ws + WS_MODP); float* mod = (float*)(a.ws + WS_MOD);
    for (int idx = bid * 512 + tid; idx < 2 * 8 * MODW; idx += G * 512) {
        const int i = idx / (8 * MODW), rem = idx % (8 * MODW), j = rem % MODW;
        float v = a.in[I_ADAB][i * MODW + j];
#pragma unroll
        for (int ks = 0; ks < 4; ++ks) v += modp[(size_t)(ks * 2 + i) * (8 * MODW) + rem];
        mod[idx] = v; }
}

__device__ __forceinline__ void dt_phase(const Args& a, int bid, int G, int lane, int wave) {
    const bf16* H = (const bf16*)(a.ws + WS_H); const bf16* WT = (const bf16*)(a.ws + WS_WIN); float* DT = (float*)(a.ws + WS_DT);
    const int fr = lane & 15, fq = lane >> 4;
    const f32x4 bias0 = *(const f32x4*)(a.in[I_DTB] + 4 * fq), bias1 = *(const f32x4*)(a.in[I_DTB] + 16 + 4 * fq);
    for (int it = bid * 8 + wave; it < M / 16; it += G * 8) {
        const int m0 = it * 16;
        const bf16* ap = H + (size_t)(m0 + fr) * D + 8 * fq;
        const bf16* bp0 = WT + (size_t)(5120 + fr) * D + 8 * fq; const bf16* bp1 = bp0 + (size_t)16 * D;
        f32x4 acc0 = {0.f, 0.f, 0.f, 0.f}, acc1 = {0.f, 0.f, 0.f, 0.f};
#pragma unroll 4
        for (int k0 = 0; k0 < D; k0 += 32) {
            const bf16x8 av = *(const bf16x8*)(ap + k0), b0 = *(const bf16x8*)(bp0 + k0), b1 = *(const bf16x8*)(bp1 + k0);
            acc0 = __builtin_amdgcn_mfma_f32_16x16x32_bf16(b0, av, acc0, 0, 0, 0);
            acc1 = __builtin_amdgcn_mfma_f32_16x16x32_bf16(b1, av, acc1, 0, 0, 0); }
        f32x4 o0, o1;
#pragma unroll
        for (int j = 0; j < 4; ++j) { const float x0 = acc0[j] + bias0[j], x1 = acc1[j] + bias1[j];
            o0[j] = fmaxf(x0, 0.f) + log1pf(expf(-fabsf(x0))); o1[j] = fmaxf(x1, 0.f) + log1pf(expf(-fabsf(x1))); }
        *(f32x4*)(DT + (size_t)(m0 + fr) * NH + 4 * fq) = o0; *(f32x4*)(DT + (size_t)(m0 + fr) * NH + 16 + 4 * fq) = o1;
    }
}
constexpr int RSB = 272;
constexpr int S_BM = 0, S_CM = 34816, S_BDT = 69632, S_XDT = 104448, S_ST = 121856, S_ACS = 139264, S_DTV = 139776, S_CW = 140288;
static_assert(S_CW + 5 * 320 * 4 <= LDS_BYTES, "SSD LDS map");
__device__ __forceinline__ float wave_scan_incl(float v, int lane) {
#pragma unroll
    for (int o = 1; o < 64; o <<= 1) { const float t = __shfl_up(v, o); if (lane >= o) v += t; }
    return v;
}
template <int NR>
__device__ __forceinline__ void conv_col(const u32x4 (&raw)[NR + 3], int j, const LAS float* cw, float (&o)[NR]) {
    float rf[NR + 3];
#pragma unroll
    for (int i = 0; i < NR + 3; ++i) { const unsigned w = raw[i][j >> 1]; rf[i] = (j & 1) ? bfhi(w) : bflo(w); }
    const float w0 = cw[j], w1 = cw[320 + j], w2 = cw[640 + j], w3 = cw[960 + j], bb = cw[1280 + j];
#pragma unroll
    for (int i = 0; i < NR; ++i) o[i] = silu_f(bb + w0 * rf[i] + w1 * rf[i + 1] + w2 * rf[i + 2] + w3 * rf[i + 3]);
}
__device__ __forceinline__ void ssd_phase(const Args& a, LAS unsigned char* lds, int bid, int G, int tid, int lane, int wave) {
    const bf16* XBC = (const bf16*)(a.ws + WS_XBC); bf16* Z = (bf16*)(a.ws + WS_Z); const float* DT = (const float*)(a.ws + WS_DT); float* SS = (float*)(a.ws + WS_SS);
    const int fr = lane & 15, fq = lane >> 4;
    LAS float* Acs = (LAS float*)(lds + S_ACS); LAS float* dtv = (LAS float*)(lds + S_DTV); LAS float* CW = (LAS float*)(lds + S_CW);
    for (int item = bid; item < 256; item += G) {
        const int xcd = item & 7, jj = item >> 3, pg = xcd * 4 + (jj >> 3), hh = jj & 7, b = pg >> 2, g = pg & 3, h = g * 8 + hh;
        const float A_h = -expf(a.in[I_ALOG][h]), D_h = a.in[I_DSK][h];
        __syncthreads();
        for (int i = tid; i < 5 * 320; i += 512) { const int k = i / 320, cl = i % 320;
            const int ch = cl < 64 ? h * 64 + cl : (cl < 192 ? 2048 + g * 128 + (cl - 64) : 2560 + g * 128 + (cl - 192));
            CW[i] = (k < 4) ? a.in[I_SSDCW][k * NCV + ch] : a.in[I_SSDCB][ch]; }
        for (int i = tid; i < 17408 / 4; i += 512) ((LAS unsigned*)(lds + S_ST))[i] = 0u;
        f32x4 sacc[4];
#pragma unroll
        for (int pb = 0; pb < 4; ++pb) sacc[pb] = (f32x4){0.f, 0.f, 0.f, 0.f};
        __syncthreads();
        for (int c = 0; c < 16; ++c) {
            const int t0 = b * SEQ + c * 128;
            if (wave < 2) {
                const float d0 = DT[(size_t)(t0 + lane) * NH + h];
                const float s0 = wave_scan_incl(d0 * A_h, lane);
                if (wave == 0) { Acs[lane] = s0; dtv[lane] = d0; }
                else { const float tot0 = __shfl(s0, 63); const float d1 = DT[(size_t)(t0 + 64 + lane) * NH + h];
                       const float s1 = wave_scan_incl(d1 * A_h, lane); Acs[64 + lane] = s1 + tot0; dtv[64 + lane] = d1; }
            }
            {
                const int cgp = tid & 15, rs = tid >> 4;
                const bf16* src = XBC + (ptrdiff_t)(t0 + 4 * rs - 3) * NCV + 2560 + g * 128 + 8 * cgp;
                u32x4 raw[7];
#pragma unroll
                for (int i = 0; i < 7; ++i) { const bool ok = (c > 0) || (4 * rs - 3 + i >= 0); raw[i] = ok ? *(const u32x4*)(src + (ptrdiff_t)i * NCV) : (u32x4){0u, 0u, 0u, 0u}; }
                unsigned pk[4][4];
#pragma unroll
                for (int j2 = 0; j2 < 4; ++j2) { float oa[4], ob[4]; conv_col<4>(raw, 2 * j2, CW + 192 + 8 * cgp, oa); conv_col<4>(raw, 2 * j2 + 1, CW + 192 + 8 * cgp, ob);
#pragma unroll
                    for (int i = 0; i < 4; ++i) pk[i][j2] = pk2(oa[i], ob[i]); }
#pragma unroll
                for (int i = 0; i < 4; ++i) *(LAS u32x4*)(lds + S_CM + (4 * rs + i) * RSB + cgp * 16) = (u32x4){pk[i][0], pk[i][1], pk[i][2], pk[i][3]};
            }
            __syncthreads();
            {
                const int cgp = tid & 15, rs = tid >> 4;
                const bf16* src = XBC + (ptrdiff_t)(t0 + 4 * rs - 3) * NCV + 2048 + g * 128 + 8 * cgp;
                u32x4 raw[7];
#pragma unroll
                for (int i = 0; i < 7; ++i) { const bool ok = (c > 0) || (4 * rs - 3 + i >= 0); raw[i] = ok ? *(const u32x4*)(src + (ptrdiff_t)i * NCV) : (u32x4){0u, 0u, 0u, 0u}; }
                const float alast = Acs[127]; const f32x4 as4 = *(const LAS f32x4*)(Acs + 4 * rs);
                float E[4];
#pragma unroll
                for (int i = 0; i < 4; ++i) E[i] = fexp(alast - as4[i]);
                unsigned pk[4][4];
#pragma unroll
                for (int j2 = 0; j2 < 4; ++j2) { float oa[4], ob[4]; conv_col<4>(raw, 2 * j2, CW + 64 + 8 * cgp, oa); conv_col<4>(raw, 2 * j2 + 1, CW + 64 + 8 * cgp, ob);
#pragma unroll
                    for (int i = 0; i < 4; ++i) pk[i][j2] = pk2(oa[i], ob[i]);
                    *(LAS u32x2*)(lds + S_BDT + (8 * cgp + 2 * j2) * RSB + rs * 8) = (u32x2){pk2(oa[0] * E[0], oa[1] * E[1]), pk2(oa[2] * E[2], oa[3] * E[3])};
                    *(LAS u32x2*)(lds + S_BDT + (8 * cgp + 2 * j2 + 1) * RSB + rs * 8) = (u32x2){pk2(ob[0] * E[0], ob[1] * E[1]), pk2(ob[2] * E[2], ob[3] * E[3])}; }
#pragma unroll
                for (int i = 0; i < 4; ++i) *(LAS u32x4*)(lds + S_BM + (4 * rs + i) * RSB + cgp * 16) = (u32x4){pk[i][0], pk[i][1], pk[i][2], pk[i][3]};
            }
            {
                const int cgp = tid & 7, rs = tid >> 3;
                const bf16* src = XBC + (ptrdiff_t)(t0 + 2 * rs - 3) * NCV + h * 64 + 8 * cgp;
                u32x4 raw[5];
#pragma unroll
                for (int i = 0; i < 5; ++i) { const bool ok = (c > 0) || (2 * rs - 3 + i >= 0); raw[i] = ok ? *(const u32x4*)(src + (ptrdiff_t)i * NCV) : (u32x4){0u, 0u, 0u, 0u}; }
                const float d0 = dtv[2 * rs], d1 = dtv[2 * rs + 1];
#pragma unroll
                for (int j = 0; j < 8; ++j) { float o[2]; conv_col<2>(raw, j, CW + 8 * cgp, o);
                    *(LAS unsigned*)(lds + S_XDT + (8 * cgp + j) * RSB + rs * 4) = pk2(o[0] * d0, o[1] * d1); }
            }
            __syncthreads();
            bf16x8 Cf[4];
#pragma unroll
            for (int kk = 0; kk < 4; ++kk) Cf[kk] = *(const LAS bf16x8*)(lds + S_CM + (16 * wave + fr) * RSB + (32 * kk + 8 * fq) * 2);
            unsigned Mw[4][4];
#pragma unroll
            for (int kb = 0; kb < 4; ++kb)
#pragma unroll
                for (int e = 0; e < 4; ++e) Mw[kb][e] = 0u;
            const float acs_l = Acs[16 * wave + fr]; const int lidx = 16 * wave + fr;
#pragma unroll
            for (int sb = 0; sb < 8; ++sb) {
                if (sb <= wave) {
                    f32x4 s = {0.f, 0.f, 0.f, 0.f};
#pragma unroll
                    for (int kk = 0; kk < 4; ++kk) { const bf16x8 af = *(const LAS bf16x8*)(lds + S_BM + (16 * sb + fr) * RSB + (32 * kk + 8 * fq) * 2);
                        s = __builtin_amdgcn_mfma_f32_16x16x32_bf16(af, Cf[kk], s, 0, 0, 0); }
                    const f32x4 as4 = *(const LAS f32x4*)(Acs + 16 * sb + 4 * fq);
                    float v[4];
#pragma unroll
                    for (int i = 0; i < 4; ++i) { const int sidx = 16 * sb + 4 * fq + i; const float e = fexp(fminf(acs_l - as4[i], 0.f)); v[i] = (sidx <= lidx) ? s[i] * e : 0.f; }
                    Mw[sb >> 1][(sb & 1) * 2 + 0] = pk2(v[0], v[1]); Mw[sb >> 1][(sb & 1) * 2 + 1] = pk2(v[2], v[3]);
                }
            }
            f32x4 yd[4], yo[4];
#pragma unroll
            for (int pb = 0; pb < 4; ++pb) { yd[pb] = (f32x4){0.f, 0.f, 0.f, 0.f}; yo[pb] = (f32x4){0.f, 0.f, 0.f, 0.f}; }
#pragma unroll
            for (int kb = 0; kb < 4; ++kb) {
                if (2 * kb <= wave) {
                    const u32x4 mw = {Mw[kb][0], Mw[kb][1], Mw[kb][2], Mw[kb][3]}; const bf16x8 mf = __builtin_bit_cast(bf16x8, mw);
#pragma unroll
                    for (int pb = 0; pb < 4; ++pb) { const u32x2 lo = *(const LAS u32x2*)(lds + S_XDT + (16 * pb + fr) * RSB + (32 * kb + 4 * fq) * 2);
                        const u32x2 hi = *(const LAS u32x2*)(lds + S_XDT + (16 * pb + fr) * RSB + (32 * kb + 16 + 4 * fq) * 2);
                        const u32x4 xw = {lo.x, lo.y, hi.x, hi.y};
                        yd[pb] = __builtin_amdgcn_mfma_f32_16x16x32_bf16(mf, __builtin_bit_cast(bf16x8, xw), yd[pb], 0, 0, 0); }
                }
            }
            if (c > 0) {
#pragma unroll
                for (int kk = 0; kk < 4; ++kk)
#pragma unroll
                    for (int pb = 0; pb < 4; ++pb) { const bf16x8 sf = *(const LAS bf16x8*)(lds + S_ST + (16 * pb + fr) * RSB + (32 * kk + 8 * fq) * 2);
                        yo[pb] = __builtin_amdgcn_mfma_f32_16x16x32_bf16(Cf[kk], sf, yo[pb], 0, 0, 0); }
            }
            {
                const f32x4 al4 = *(const LAS f32x4*)(Acs + 16 * wave + 4 * fq), dt4 = *(const LAS f32x4*)(dtv + 16 * wave + 4 * fq);
                float ea[4], rdt[4], ssq[4];
#pragma unroll
                for (int i = 0; i < 4; ++i) { ea[i] = fexp(al4[i]); rdt[i] = 1.0f / dt4[i]; ssq[i] = 0.f; }
#pragma unroll
                for (int pb = 0; pb < 4; ++pb) {
                    const u32x2 xd = *(const LAS u32x2*)(lds + S_XDT + (16 * pb + fr) * RSB + (16 * wave + 4 * fq) * 2);
                    const float xv[4] = {bflo(xd.x), bfhi(xd.x), bflo(xd.y), bfhi(xd.y)};
#pragma unroll
                    for (int i = 0; i < 4; ++i) {
                        bf16* zp = Z + (size_t)(t0 + 16 * wave + 4 * fq + i) * DIN + h * 64 + 16 * pb + fr;
                        const float z = bf1(*zp);
                        const float y = yd[pb][i] + ea[i] * yo[pb][i] + D_h * xv[i] * rdt[i];
                        const float yz = y * silu_f(z);
                        *zp = (bf16)(pk2(yz, 0.f) & 0xffffu); ssq[i] += yz * yz;
                    }
                }
#pragma unroll
                for (int i = 0; i < 4; ++i) { float s = ssq[i]; s += __shfl_xor(s, 1); s += __shfl_xor(s, 2); s += __shfl_xor(s, 4); s += __shfl_xor(s, 8);
                    if (fr == 0) SS[(size_t)(t0 + 16 * wave + 4 * fq + i) * NH + h] = s; }
            }
            if (c < 15) {
                const float dec = fexp(Acs[127]);
#pragma unroll
                for (int pb = 0; pb < 4; ++pb) sacc[pb] = sacc[pb] * dec;
#pragma unroll
                for (int ks = 0; ks < 4; ++ks) { const bf16x8 bfr = *(const LAS bf16x8*)(lds + S_BDT + (16 * wave + fr) * RSB + (32 * ks + 8 * fq) * 2);
#pragma unroll
                    for (int pb = 0; pb < 4; ++pb) { const bf16x8 xf = *(const LAS bf16x8*)(lds + S_XDT + (16 * pb + fr) * RSB + (32 * ks + 8 * fq) * 2);
                        sacc[pb] = __builtin_amdgcn_mfma_f32_16x16x32_bf16(bfr, xf, sacc[pb], 0, 0, 0); } }
            }
            __syncthreads();
            if (c < 15) {
#pragma unroll
                for (int pb = 0; pb < 4; ++pb) *(LAS u32x2*)(lds + S_ST + (16 * pb + fr) * RSB + (16 * wave + 4 * fq) * 2) = (u32x2){pk2(sacc[pb][0], sacc[pb][1]), pk2(sacc[pb][2], sacc[pb][3])};
            }
        }
    }
}

__device__ __forceinline__ void gnorm_phase(const Args& a, int bid, int G, int lane, int wave) {
    bf16* YZ = (bf16*)(a.ws + WS_Z); const float* SS = (const float*)(a.ws + WS_SS); const float* nw = a.in[I_SSDNW];
    for (int row = bid * 8 + wave; row < M; row += G * 8) {
#pragma unroll
        for (int g = 0; g < 4; ++g) {
            u32x4* p = (u32x4*)(YZ + (size_t)row * DIN + g * 512 + lane * 8);
            const u32x4 v = *p;
            float s = SS[(size_t)row * NH + g * 8 + (lane & 7)]; s += __shfl_xor(s, 1); s += __shfl_xor(s, 2); s += __shfl_xor(s, 4);
            const float rs = __builtin_amdgcn_rsqf(s * (1.0f / 512.0f) + EPS);
            const f32x4 w0 = *(const f32x4*)(nw + g * 512 + lane * 8), w1 = *(const f32x4*)(nw + g * 512 + lane * 8 + 4);
            u32x4 o; o.x = pk2(bflo(v.x) * rs * w0.x, bfhi(v.x) * rs * w0.y); o.y = pk2(bflo(v.y) * rs * w0.z, bfhi(v.y) * rs * w0.w);
            o.z = pk2(bflo(v.z) * rs * w1.x, bfhi(v.z) * rs * w1.y); o.w = pk2(bflo(v.w) * rs * w1.z, bfhi(v.w) * rs * w1.w);
            *p = o;
        }
    }
}

__device__ __forceinline__ void sconv_phase(const Args& a, int bid, int G, int lane, int wave) {
    const bf16* P = (const bf16*)(a.ws + WS_PROJ); bf16* Y = (bf16*)(a.ws + WS_YSC); const float* cw = a.in[I_SCCW];
    for (int it = bid * 8 + wave; it < 2048; it += G * 8) {
        const int seg = it >> 1, col = (it & 1) * 512 + lane * 8, row0 = seg * 16;
        float w[3][8];
#pragma unroll
        for (int k = 0; k < 3; ++k) { const f32x4 a0 = *(const f32x4*)(cw + k * D + col), a1 = *(const f32x4*)(cw + k * D + col + 4);
            w[k][0] = a0.x; w[k][1] = a0.y; w[k][2] = a0.z; w[k][3] = a0.w; w[k][4] = a1.x; w[k][5] = a1.y; w[k][6] = a1.z; w[k][7] = a1.w; }
        float u2[8], u1[8];
#pragma unroll
        for (int j = 0; j < 8; ++j) { u2[j] = 0.f; u1[j] = 0.f; }
        if ((row0 & (SEQ - 1)) != 0) {
            const u32x4 c2 = *(const u32x4*)(P + (size_t)(row0 - 2) * NCV + D + col), x2 = *(const u32x4*)(P + (size_t)(row0 - 2) * NCV + 2 * D + col);
            const u32x4 c1 = *(const u32x4*)(P + (size_t)(row0 - 1) * NCV + D + col), x1 = *(const u32x4*)(P + (size_t)(row0 - 1) * NCV + 2 * D + col);
#pragma unroll
            for (int q = 0; q < 4; ++q) { u2[2 * q] = bflo(c2[q]) * bflo(x2[q]); u2[2 * q + 1] = bfhi(c2[q]) * bfhi(x2[q]); u1[2 * q] = bflo(c1[q]) * bflo(x1[q]); u1[2 * q + 1] = bfhi(c1[q]) * bfhi(x1[q]); }
        }
#pragma unroll 4
        for (int r = 0; r < 16; ++r) {
            const bf16* rp = P + (size_t)(row0 + r) * NCV + col;
            const u32x4 bg = *(const u32x4*)rp, cv = *(const u32x4*)(rp + D), xv = *(const u32x4*)(rp + 2 * D);
            float u0[8], y[8];
#pragma unroll
            for (int q = 0; q < 4; ++q) { u0[2 * q] = bflo(cv[q]) * bflo(xv[q]); u0[2 * q + 1] = bfhi(cv[q]) * bfhi(xv[q]); }
#pragma unroll
            for (int j = 0; j < 8; ++j) { const float bgv = (j & 1) ? bfhi(bg[j >> 1]) : bflo(bg[j >> 1]); y[j] = bgv * (w[0][j] * u2[j] + w[1][j] * u1[j] + w[2][j] * u0[j]); u2[j] = u1[j]; u1[j] = u0[j]; }
            *(u32x4*)(Y + (size_t)(row0 + r) * D + col) = (u32x4){pk2(y[0], y[1]), pk2(y[2], y[3]), pk2(y[4], y[5]), pk2(y[6], y[7])};
        }
    }
}

__device__ __forceinline__ void fnorm_phase(const Args& a, int bid, int G, int lane, int wave) {
    const float* gw = a.in[I_FNW];
    for (int row = bid * 8 + wave; row < M; row += G * 8) {
        f32x4* xr = (f32x4*)(a.out + (size_t)row * D) + lane;
        f32x4 v[4]; float s = 0.f;
#pragma unroll
        for (int j = 0; j < 4; ++j) { v[j] = xr[64 * j]; s += (v[j].x * v[j].x + v[j].y * v[j].y) + (v[j].z * v[j].z + v[j].w * v[j].w); }
        const float rstd = __builtin_amdgcn_rsqf(wave_sum(s) * (1.f / D) + EPS);
#pragma unroll
        for (int j = 0; j < 4; ++j) { const f32x4 w = *(const f32x4*)(gw + 4 * lane + 256 * j); xr[64 * j] = v[j] * rstd * w; }
    }
}

__device__ __forceinline__ void gsync(cg::grid_group& grid) {
    asm volatile("s_waitcnt vmcnt(0) lgkmcnt(0)" ::: "memory");
    __threadfence();
    grid.sync();
    __threadfence();
}
template <class Epi>
__device__ __forceinline__ void run_gemm(LAS unsigned char* lds, const bf16* A, const bf16* Bt, int N, int K, const Epi& E, int G, int bid) {
    pg8::Gemm g{A, Bt, M, N, K}; pg8::StaticOrder S; S.init(M, N, G, bid);
    pg8::gemm_phase<Epi, pg8::StaticOrder, true, true>(lds, g, S, E);
}

__global__ void __launch_bounds__(512, 2) mk_fwd(Args a) {
    extern __shared__ __attribute__((aligned(16))) unsigned char lds_raw[];
    LAS unsigned char* lds = (LAS unsigned char*)lds_raw;
    cg::grid_group grid = cg::this_grid();
    const int tid = threadIdx.x, lane = tid & 63, wave = __builtin_amdgcn_readfirstlane(tid >> 6), bid = blockIdx.x, G = gridDim.x;
    unsigned char* ws = a.ws;
    bf16* H = (bf16*)(ws + WS_H);
    const float* MOD = (const float*)(ws + WS_MOD);

    p0_phase(a, lds, bid, G, tid, lane, wave);
    gsync(grid);
    mod_finalize(a, bid, G, tid);
    norm_phase<true>(a, lds, a.in[I_X], a.in[I_MIXNW], 0, 0, 1024, H, bid, G, tid, lane, wave);
    gsync(grid);
    { pg8::EpiBf16S<0> E{(bf16*)(ws + WS_Z), DIN, (bf16*)(ws + WS_XBC), NCV, DIN};
      run_gemm(lds, H, (const bf16*)(ws + WS_WIN), 5120, D, E, G, bid); }
    dt_phase(a, bid, G, lane, wave);
    gsync(grid);
    ssd_phase(a, lds, bid, G, tid, lane, wave);
    gsync(grid);
    gnorm_phase(a, bid, G, lane, wave);
    gsync(grid);
    { pg8::EpiRes E{a.in[I_X], a.out, MOD + 2048};
      run_gemm(lds, (const bf16*)(ws + WS_Z), (const bf16*)(ws + WS_WOUT), D, DIN, E, G, bid); }
    gsync(grid);
    norm_phase<false>(a, lds, a.out, a.in[I_MLPNW], 0, 3072, 4096, H, bid, G, tid, lane, wave);
    gsync(grid);
    { pg8::EpiBf16S<2> E{(bf16*)(ws + WS_ACT), DFF, (bf16*)(ws + WS_ACT), DFF, 1 << 30};
      run_gemm(lds, H, (const bf16*)(ws + WS_WUP0), DFF, D, E, G, bid); }
    gsync(grid);
    { pg8::EpiRes E{a.out, a.out, MOD + 5120};
      run_gemm(lds, (const bf16*)(ws + WS_ACT), (const bf16*)(ws + WS_WDN0), D, DFF, E, G, bid); }
    gsync(grid);
    norm_phase<false>(a, lds, a.out, a.in[I_MIXNW] + D, 1, 0, 1024, H, bid, G, tid, lane, wave);
    gsync(grid);
    { pg8::EpiBf16S<0> E{(bf16*)(ws + WS_PROJ), NCV, (bf16*)(ws + WS_PROJ), NCV, 1 << 30};
      run_gemm(lds, H, (const bf16*)(ws + WS_WSCIN), NCV, D, E, G, bid); }
    gsync(grid);
    sconv_phase(a, bid, G, lane, wave);
    gsync(grid);
    { pg8::EpiRes E{a.out, a.out, MOD + 8 * MODW + 2048};
      run_gemm(lds, (const bf16*)(ws + WS_YSC), (const bf16*)(ws + WS_WSCOUT), D, D, E, G, bid); }
    gsync(grid);
    norm_phase<false>(a, lds, a.out, a.in[I_MLPNW] + D, 1, 3072, 4096, H, bid, G, tid, lane, wave);
    gsync(grid);
    { pg8::EpiBf16S<2> E{(bf16*)(ws + WS_ACT), DFF, (bf16*)(ws + WS_ACT), DFF, 1 << 30};
      run_gemm(lds, H, (const bf16*)(ws + WS_WUP1), DFF, D, E, G, bid); }
    gsync(grid);
    { pg8::EpiRes E{a.out, a.out, MOD + 8 * MODW + 5120};
      run_gemm(lds, (const bf16*)(ws + WS_ACT), (const bf16*)(ws + WS_WDN1), D, DFF, E, G, bid); }
    gsync(grid);
    fnorm_phase(a, bid, G, lane, wave);
}

extern "C" void kernel_launch(void* const* d_in, const int* in_sizes, int n_in, void* d_out, int out_size, void* d_ws, size_t ws_size, hipStream_t stream) {
    static int grid = 0;
    if (grid == 0) {
        if (n_in != 20 || in_sizes[0] != M * D || out_size != M * D || ws_size < WS_END) { fprintf(stderr, "kernel_launch: unexpected shapes (n_in %d, in0 %d, out %d, ws %zu)\n", n_in, n_in > 0 ? in_sizes[0] : -1, out_size, ws_size); grid = -1; return; }
        int dev = 0, cus = 0, per_cu = 0;
        hipGetDevice(&dev); hipDeviceGetAttribute(&cus, hipDeviceAttributeMultiprocessorCount, dev);
        if (hipFuncSetAttribute((const void*)mk_fwd, hipFuncAttributeMaxDynamicSharedMemorySize, LDS_BYTES) != hipSuccess) { fprintf(stderr, "kernel_launch: hipFuncSetAttribute failed\n"); grid = -1; return; }
        if (hipOccupancyMaxActiveBlocksPerMultiprocessor(&per_cu, (const void*)mk_fwd, 512, LDS_BYTES) != hipSuccess || per_cu < 1) { fprintf(stderr, "kernel_launch: occupancy query says %d blocks per CU\n", per_cu); (void)hipGetLastError(); per_cu = 1; }
        grid = cus;
        if (grid <= 0) { grid = -1; return; }
    }
    if (grid < 0) return;
    Args a{};
    for (int i = 0; i < 20; ++i) a.in[i] = (const float*)d_in[i];
    a.out = (float*)d_out; a.ws = (unsigned char*)d_ws;
    void* args[] = {&a};
    hipError_t e = hipLaunchCooperativeKernel((const void*)mk_fwd, dim3(grid), dim3(512), args, LDS_BYTES, stream);
    if (e != hipSuccess) fprintf(stderr, "cooperative launch failed: %s (grid %d)\n", hipGetErrorString(e), grid);
}
```

```cpp
#include <hip/hip_runtime.h>
#include <hip/hip_cooperative_groups.h>
#include <cstdio>
#include <cstdint>
namespace cg = cooperative_groups;
namespace pg8 {
#define PG8_LAS __attribute__((address_space(3)))
typedef unsigned short bf16_t;
typedef short bf16x8 __attribute__((ext_vector_type(8)));
typedef float f32x4 __attribute__((ext_vector_type(4)));
typedef unsigned u32x4 __attribute__((ext_vector_type(4)));
constexpr int BM = 256, BK = 64, HALF = 128, HTB = HALF * BK * 2  , STAGE_BYTES = 8 * HTB, NXCD = 8, WGM = 8;

__host__ __device__ __forceinline__ int lds_byte(int r, int c) { const int st = (r >> 4) * 2 + (c >> 5), rr = r & 15, cc = c & 31, ob = rr * 64 + cc * 2; return st * 1024 + (ob ^ (((ob >> 9) & 1) << 5)); }
__host__ __device__ __forceinline__ void stage_rc(int b, int& R, int& C) { const int st = b / 1024, sb = b % 1024, swz = sb ^ (((sb >> 9) & 1) << 5); R = (st >> 1) * 16 + swz / 64; C = (st & 1) * 32 + (swz % 64) / 2; }
__host__ __device__ __forceinline__ int perm32(int rho) { const int n = rho >> 4, i = rho & 15; return 8 * (i >> 2) + 4 * n + (i & 3); }

struct Unit { int pm, pn; };
struct Gemm { const bf16_t* A; const bf16_t* Bt; int M, N, K; };

struct StaticOrder {
    int nM, nN, nwg, G, c;
    __host__ __device__ void init(int M, int N, int G_, int c_) { nM = M / BM; nN = N / BM; nwg = nM * nN; G = G_; c = c_; }
    __host__ __device__ bool next(int i, Unit& u) const {
        const long L = (long)i * G + c; if (L >= nwg) return false;
        int wgid = (int)L; { const int q = nwg / NXCD, r = nwg % NXCD, xcd = wgid % NXCD, off = wgid / NXCD; wgid = (xcd < r ? xcd * (q + 1) : r * (q + 1) + (xcd - r) * q) + off; }
        const int nig = WGM * nN, gid = wgid / nig, fm = gid * WGM, gsz = (nM - fm) < WGM ? (nM - fm) : WGM;
        u.pm = fm + ((wgid % nig) % gsz); u.pn = (wgid % nig) / gsz; return true;
    }
    __device__ __forceinline__ void a_ready(const Unit&) const {}
    __device__ __forceinline__ void done(const Unit&) const {}
};
__device__ __forceinline__ unsigned cvt_pk_bf16(float lo, float hi) { unsigned r; asm volatile("v_cvt_pk_bf16_f32 %0, %1, %2" : "=v"(r) : "v"(lo), "v"(hi)); return r; }
typedef float f32x2 __attribute__((ext_vector_type(2)));
__device__ __forceinline__ unsigned pk2bf(float lo, float hi) { unsigned r; asm("v_cvt_pk_bf16_f32 %0, %1, %2" : "=v"(r) : "v"(lo), "v"(hi)); return r; }
template <int ACT  > struct EpiBf16S {
    static constexpr bool PERM = true, AFTER_DRAIN = false;
    bf16_t* O0; int ld0; bf16_t* O1; int ld1; int csplit;
    __device__ __forceinline__ void operator()(const f32x4 (&acc)[2][2][4][2], const Unit& u, int wr, int wc, int fr, int fq) const {
        const int row0 = u.pm * BM + wr * 64 + fr; int colt = u.pn * BM; bf16_t* base = O0; int ldc = ld0;
        if (colt >= csplit) { base = O1; ldc = ld1; colt -= csplit; }
        const int col0 = colt + wc * 32 + 8 * fq;
#pragma unroll
        for (int ai = 0; ai < 2; ++ai)
#pragma unroll
            for (int m = 0; m < 4; ++m) { bf16_t* rowp = base + (size_t)(row0 + ai * HALF + m * 16) * ldc + col0;
#pragma unroll
                for (int bj = 0; bj < 2; ++bj) { f32x4 v0 = acc[ai][bj][m][0], v1 = acc[ai][bj][m][1];
                    if (ACT == 2) {
#pragma unroll
                        for (int e = 0; e < 4; ++e) { float a0 = fmaxf(v0[e], 0.f), a1 = fmaxf(v1[e], 0.f); v0[e] = a0 * a0; v1[e] = a1 * a1; } }
                    u32x4 w; w.x = pk2bf(v0[0], v0[1]); w.y = pk2bf(v0[2], v0[3]); w.z = pk2bf(v1[0], v1[1]); w.w = pk2bf(v1[2], v1[3]);
                    *(u32x4*)(rowp + bj * HALF) = w; } }
    }
};
struct EpiRes {
    static constexpr bool PERM = false, AFTER_DRAIN = false;
    const float* base; float* out; const float* gate;
    __device__ __forceinline__ void operator()(const f32x4 (&acc)[2][2][4][2], const Unit& u, int wr, int wc, int fr, int fq) const {
        const int b = (u.pm * BM) >> 11; const float* gp = gate + (size_t)b * 6144;
        const int col0 = u.pn * BM + wc * 32 + 4 * fq;
        f32x4 gv[2][2];
#pragma unroll
        for (int bj = 0; bj < 2; ++bj)
#pragma unroll
            for (int n = 0; n < 2; ++n) gv[bj][n] = *(const f32x4*)(gp + col0 + bj * HALF + n * 16);
#pragma unroll
        for (int ai = 0; ai < 2; ++ai)
#pragma unroll
            for (int m = 0; m < 4; ++m) { const size_t off = (size_t)(u.pm * BM + ai * HALF + wr * 64 + m * 16 + fr) * 1024 + col0;
#pragma unroll
                for (int bj = 0; bj < 2; ++bj)
#pragma unroll
                    for (int n = 0; n < 2; ++n) { const f32x4 bs = *(const f32x4*)(base + off + bj * HALF + n * 16);
                        *(f32x4*)(out + off + bj * HALF + n * 16) = bs + gv[bj][n] * acc[ai][bj][m][n]; }
                asm volatile("" ::: "memory"); }
    }
};

template <class Epi, class Sched, bool ALIGN_EPI = false, bool SP2 = false>
__device__ __forceinline__ void gemm_phase(PG8_LAS unsigned char* lds, const Gemm g, const Sched& S, const Epi& E) {
    const int tid = threadIdx.x, wid = __builtin_amdgcn_readfirstlane(tid >> 6), lane = tid & 63, wr = wid >> 2, wc = wid & 3, fr = lane & 15, fq = lane >> 4;
    const int K = g.K, nt = K / BK;
    unsigned voffA[2], voffB[2];
#pragma unroll
    for (int i = 0; i < 2; ++i) { int R, C; stage_rc(tid * 16 + i * 8192, R, C); const int Rb = Epi::PERM ? ((R & ~31) + perm32(R & 31)) : R;
        voffA[i] = (unsigned)(R * K + C) * 2u; voffB[i] = (unsigned)(Rb * K + C) * 2u; }
    const size_t kstep = (size_t)(BK * 2);
    const size_t hstep = (size_t)HALF * K * 2;
    const size_t tstep = 2 * hstep;
    const unsigned ldsw = (unsigned)wid * 1024u;
    const int aoff = lds_byte(wr * 64 + fr, fq * 8), boff = lds_byte(wc * 32 + fr, fq * 8);
#define PG8_SA(b, h) (((b) * 2 + (h)) * HTB)
#define PG8_SB(b, h) ((4 + (b) * 2 + (h)) * HTB)
#define PG8_STAGE(bufoff, gbase, voff) do { _Pragma("unroll") for (int _i = 0; _i < 2; ++_i) \
        __builtin_amdgcn_global_load_lds((const unsigned*)((const char*)(gbase) + (voff)[_i]), (PG8_LAS unsigned*)(lds + (bufoff) + ldsw + _i * 8192), 16, 0, 0); } while (0)
#define PG8_LDA(dst, b, h) do { _Pragma("unroll") for (int m = 0; m < 4; ++m) _Pragma("unroll") for (int k = 0; k < 2; ++k) dst[m][k] = *(const PG8_LAS bf16x8*)(lds + PG8_SA(b, h) + aoff + m * 2048 + k * 1024); } while (0)
#define PG8_LDB(dst, b, h) do { _Pragma("unroll") for (int n = 0; n < 2; ++n) _Pragma("unroll") for (int k = 0; k < 2; ++k) dst[n][k] = *(const PG8_LAS bf16x8*)(lds + PG8_SB(b, h) + boff + n * 2048 + k * 1024); } while (0)
#define PG8_MMA(ai, bj, At, Bt) do { __builtin_amdgcn_s_setprio(1); _Pragma("unroll") for (int m = 0; m < 4; ++m) _Pragma("unroll") for (int n = 0; n < 2; ++n) _Pragma("unroll") for (int k = 0; k < 2; ++k) \
        acc[ai][bj][m][n] = __builtin_amdgcn_mfma_f32_16x16x32_bf16(Bt[n][k], At[m][k], acc[ai][bj][m][n], 0, 0, 0); __builtin_amdgcn_s_setprio(0); } while (0)
#define PG8_WAIT_V(n) asm volatile("s_waitcnt vmcnt(" #n ")" ::: "memory")
#define PG8_WAIT_L(n) asm volatile("s_waitcnt lgkmcnt(" #n ")" ::: "memory")
#define PG8_BAR __builtin_amdgcn_s_barrier()
#define PG8_SCHED __builtin_amdgcn_sched_barrier(0)
    Unit cur, nxt; int ui = 0;
    if (!S.next(0, cur)) return;
    f32x4 acc[2][2][4][2];
#pragma unroll
    for (int a = 0; a < 2; ++a)
#pragma unroll
        for (int b = 0; b < 2; ++b)
#pragma unroll
            for (int m = 0; m < 4; ++m)
#pragma unroll
                for (int n = 0; n < 2; ++n) acc[a][b][m][n] = (f32x4){0.f, 0.f, 0.f, 0.f};
    bf16x8 At[4][2], B0[2][2], B1[2][2];
    const char* cA = (const char*)g.A + (size_t)cur.pm * tstep; const char* cB = (const char*)g.Bt + (size_t)cur.pn * tstep;
    S.a_ready(cur);
    if constexpr (SP2) {
        PG8_STAGE(PG8_SB(0, 0), cB, voffB); PG8_STAGE(PG8_SB(0, 1), cB + hstep, voffB); PG8_STAGE(PG8_SA(0, 0), cA, voffA); PG8_STAGE(PG8_SA(0, 1), cA + hstep, voffA);
        if (wr == 1) PG8_BAR;
        PG8_WAIT_V(2); PG8_BAR;
        PG8_STAGE(PG8_SB(1, 0), cB + kstep, voffB); PG8_STAGE(PG8_SA(1, 0), cA + kstep, voffA); PG8_STAGE(PG8_SB(1, 1), cB + hstep + kstep, voffB);
        PG8_WAIT_V(6); PG8_BAR;
    } else {
        PG8_STAGE(PG8_SB(0, 0), cB, voffB); PG8_STAGE(PG8_SA(0, 0), cA, voffA); PG8_STAGE(PG8_SB(0, 1), cB + hstep, voffB); PG8_STAGE(PG8_SA(0, 1), cA + hstep, voffA);
        if (wr == 1) PG8_BAR;
        PG8_WAIT_V(4); PG8_BAR;
        PG8_STAGE(PG8_SB(1, 0), cB + kstep, voffB); PG8_STAGE(PG8_SA(1, 0), cA + kstep, voffA); PG8_STAGE(PG8_SB(1, 1), cB + hstep + kstep, voffB);
        PG8_WAIT_V(6); PG8_BAR;
    }
    for (;;) {
        const bool has_next = S.next(ui + 1, nxt);
        const char* nA = has_next ? (const char*)g.A + (size_t)nxt.pm * tstep : cA; const char* nB = has_next ? (const char*)g.Bt + (size_t)nxt.pn * tstep : cB;
        for (int t = 0; t < nt; t += 2) {
            const bool last = (t == nt - 2);
            const char* a1 = cA + (size_t)(t + 1) * kstep;
            const char* a2 = last ? nA : cA + (size_t)(t + 2) * kstep; const char* b2 = last ? nB : cB + (size_t)(t + 2) * kstep;
            const char* a3 = a2 + kstep; const char* b3 = b2 + kstep;
            if (last && has_next) S.a_ready(nxt);
            if constexpr (SP2) {
            PG8_LDB(B0, 0, 0); PG8_LDB(B1, 0, 1); PG8_SCHED; PG8_LDA(At, 0, 0); PG8_STAGE(PG8_SA(1, 1), a1 + hstep, voffA);
            PG8_WAIT_V(8); PG8_WAIT_L(0); PG8_BAR; PG8_MMA(0, 0, At, B0); PG8_MMA(0, 1, At, B1); PG8_BAR; PG8_SCHED;
            PG8_LDA(At, 0, 1); PG8_STAGE(PG8_SB(0, 0), b2, voffB); PG8_STAGE(PG8_SB(0, 1), b2 + hstep, voffB); PG8_STAGE(PG8_SA(0, 0), a2, voffA);
            PG8_WAIT_V(8); PG8_WAIT_L(0); PG8_BAR; PG8_MMA(1, 0, At, B0); PG8_MMA(1, 1, At, B1); PG8_BAR; PG8_SCHED;
            PG8_LDB(B0, 1, 0); PG8_LDB(B1, 1, 1); PG8_SCHED; PG8_LDA(At, 1, 0); PG8_STAGE(PG8_SA(0, 1), a2 + hstep, voffA);
            PG8_WAIT_V(8); PG8_WAIT_L(0); PG8_BAR; PG8_MMA(0, 0, At, B0); PG8_MMA(0, 1, At, B1); PG8_BAR; PG8_SCHED;
            PG8_LDA(At, 1, 1); PG8_STAGE(PG8_SB(1, 0), b3, voffB); PG8_STAGE(PG8_SB(1, 1), b3 + hstep, voffB); PG8_STAGE(PG8_SA(1, 0), a3, voffA);
            PG8_WAIT_V(8); PG8_WAIT_L(0); PG8_BAR; PG8_MMA(1, 0, At, B0); PG8_MMA(1, 1, At, B1); PG8_BAR; PG8_SCHED;
            } else {
            PG8_LDB(B0, 0, 0); PG8_SCHED; PG8_LDA(At, 0, 0); PG8_STAGE(PG8_SA(1, 1), a1 + hstep, voffA);
            PG8_WAIT_L(8); PG8_BAR; PG8_WAIT_L(0); PG8_MMA(0, 0, At, B0); PG8_BAR; PG8_SCHED;
            PG8_LDB(B1, 0, 1); PG8_STAGE(PG8_SB(0, 0), b2, voffB);
            PG8_BAR; PG8_WAIT_L(0); PG8_MMA(0, 1, At, B1); PG8_BAR;
            PG8_LDA(At, 0, 1); PG8_STAGE(PG8_SA(0, 0), a2, voffA);
            PG8_BAR; PG8_WAIT_L(0); PG8_MMA(1, 0, At, B0); PG8_BAR; PG8_SCHED;
            PG8_STAGE(PG8_SB(0, 1), b2 + hstep, voffB);
            PG8_WAIT_V(6); PG8_BAR; PG8_MMA(1, 1, At, B1); PG8_BAR;
            PG8_LDB(B0, 1, 0); PG8_SCHED; PG8_LDA(At, 1, 0); PG8_STAGE(PG8_SA(0, 1), a2 + hstep, voffA);
            PG8_WAIT_L(8); PG8_BAR; PG8_WAIT_L(0); PG8_MMA(0, 0, At, B0); PG8_BAR; PG8_SCHED;
            PG8_LDB(B1, 1, 1); PG8_STAGE(PG8_SB(1, 0), b3, voffB);
            PG8_BAR; PG8_WAIT_L(0); PG8_MMA(0, 1, At, B1); PG8_BAR;
            PG8_LDA(At, 1, 1); PG8_STAGE(PG8_SA(1, 0), a3, voffA);
            PG8_BAR; PG8_WAIT_L(0); PG8_MMA(1, 0, At, B0); PG8_BAR; PG8_SCHED;
            PG8_STAGE(PG8_SB(1, 1), b3 + hstep, voffB);
            PG8_WAIT_V(6); PG8_BAR; PG8_MMA(1, 1, At, B1); PG8_BAR;
            }
        }
        if constexpr (ALIGN_EPI) { if (wr == 0) PG8_BAR; }
        if constexpr (!Epi::AFTER_DRAIN) { E(acc, cur, wr, wc, fr, fq); S.done(cur); }
        if (!has_next) break;
#pragma unroll
        for (int a = 0; a < 2; ++a)
#pragma unroll
            for (int b = 0; b < 2; ++b)
#pragma unroll
                for (int m = 0; m < 4; ++m)
#pragma unroll
                    for (int n = 0; n < 2; ++n) acc[a][b][m][n] = (f32x4){0.f, 0.f, 0.f, 0.f};
        cur = nxt; cA = nA; cB = nB; ++ui;
        if constexpr (ALIGN_EPI) { if (wr == 1) PG8_BAR; }
    }
    PG8_WAIT_V(0);
    if constexpr (!ALIGN_EPI) { if (wr == 0) PG8_BAR; }
    PG8_BAR;
    if constexpr (Epi::AFTER_DRAIN) { E.fused(acc, cur, wr, wc, fr, fq, lds, wid, lane); S.done(cur); }
#undef PG8_SA
#undef PG8_SB
#undef PG8_STAGE
#undef PG8_LDA
#undef PG8_LDB
#undef PG8_MMA
#undef PG8_WAIT_V
#undef PG8_WAIT_L
#undef PG8_BAR
#undef PG8_SCHED
}
}
constexpr int SEQ = 2048, BATCH = 8, M = BATCH * SEQ, D = 1024, DFF = 4096, DIN = 2048, NCV = 3072, NH = 32, NIN = 5152, MODW = 6144;
constexpr float EPS = 1e-5f;
constexpr size_t MiB = 1u << 20;
constexpr size_t WS_MODP = 1 * MiB;
constexpr size_t WS_MOD = 2 * MiB + 512 * 1024;
constexpr size_t WS_WIN = 3 * MiB, WS_WOUT = 14 * MiB, WS_WUP0 = 18 * MiB, WS_WUP1 = 26 * MiB, WS_WDN0 = 34 * MiB, WS_WDN1 = 42 * MiB, WS_WSCIN = 50 * MiB, WS_WSCOUT = 56 * MiB;
constexpr size_t WS_DT = 58 * MiB, WS_SS = 60 * MiB, WS_H = 62 * MiB, WS_Z = 94 * MiB, WS_XBC = 158 * MiB, WS_END = 254 * MiB;
constexpr size_t WS_ACT = WS_Z, WS_PROJ = WS_Z, WS_YSC = WS_Z + 96 * MiB;
constexpr int LDS_BYTES = 147456;

#define LAS __attribute__((address_space(3)))
typedef unsigned short bf16;
typedef unsigned u32x4 __attribute__((ext_vector_type(4)));
typedef unsigned u32x2 __attribute__((ext_vector_type(2)));
typedef float f32x4 __attribute__((ext_vector_type(4)));
typedef short bf16x8 __attribute__((ext_vector_type(8)));

__device__ __forceinline__ unsigned pk2(float lo, float hi) { unsigned r; asm("v_cvt_pk_bf16_f32 %0, %1, %2" : "=v"(r) : "v"(lo), "v"(hi)); return r; }
__device__ __forceinline__ float bflo(unsigned w) { return __uint_as_float(w << 16); }
__device__ __forceinline__ float bfhi(unsigned w) { return __uint_as_float(w & 0xffff0000u); }
__device__ __forceinline__ float bf1(bf16 v) { return __uint_as_float(((unsigned)v) << 16); }
__device__ __forceinline__ float fexp(float x) { return __builtin_amdgcn_exp2f(x * 1.4426950408889634f); }
__device__ __forceinline__ float silu_f(float v) { return v * __builtin_amdgcn_rcpf(1.0f + fexp(-v)); }
__device__ __forceinline__ float wave_sum(float v) {
#pragma unroll
    for (int o = 1; o < 64; o <<= 1) v += __shfl_xor(v, o);
    return v;
}
#define LDS_WAIT() asm volatile("s_waitcnt lgkmcnt(0)" ::: "memory")

struct Args { const float* in[20]; float* out; unsigned char* ws; };
enum { I_X = 0, I_C, I_ADAW, I_ADAB, I_MIXNW, I_MLPNW, I_UP, I_DOWN, I_SSDIN, I_SSDCW, I_SSDCB, I_DTB, I_ALOG, I_DSK, I_SSDNW, I_SSDOUT, I_SCIN, I_SCCW, I_SCOUT, I_FNW };

__device__ __forceinline__ void transpose_item(const float* W, int K, int N, bf16* WT, LAS float* scr, int item, int lane) {
    const int nblk = N / 32, kb = item / nblk, nb = item % nblk, k0 = 64 * kb, n0 = 32 * nb;
#pragma unroll 8
    for (int i = 0; i < 32; ++i) { const int kk = 2 * i + (lane >> 5); scr[kk * 33 + (lane & 31)] = W[(size_t)(k0 + kk) * N + n0 + (lane & 31)]; }
    LDS_WAIT(); asm volatile("" ::: "memory");
    const int c = lane & 7;
#pragma unroll
    for (int j = 0; j < 4; ++j) { const int n = (lane >> 3) + 8 * j; const LAS float* s = scr + (8 * c) * 33 + n;
        u32x4 o; o.x = pk2(s[0 * 33], s[1 * 33]); o.y = pk2(s[2 * 33], s[3 * 33]); o.z = pk2(s[4 * 33], s[5 * 33]); o.w = pk2(s[6 * 33], s[7 * 33]);
        *(u32x4*)(WT + (size_t)(n0 + n) * K + k0 + 8 * c) = o; }
    LDS_WAIT(); asm volatile("" ::: "memory");
}

__device__ __forceinline__ void p0_phase(const Args& a, LAS unsigned char* lds, int bid, int G, int tid, int lane, int wave) {
    unsigned char* ws = a.ws;
    LAS float* cond = (LAS float*)lds;
    LAS float* red = (LAS float*)(lds + 32768);
    const float* cin = a.in[I_C];
    for (int i = tid; i < 8192; i += 512) cond[i] = silu_f(cin[i]);
    __syncthreads();
    float* modp = (float*)(ws + WS_MODP);
    for (int it = bid; it < 768; it += G) {
        const int i = it / 384, r = it % 384, cb = r >> 2, ks = r & 3, n0 = cb * 64, k0 = ks * 256 + wave * 32;
        const float* wp = a.in[I_ADAW] + ((size_t)i * 1024 + k0) * MODW + n0 + lane;
        float acc[8];
#pragma unroll
        for (int b = 0; b < 8; ++b) acc[b] = 0.f;
#pragma unroll 8
        for (int kk = 0; kk < 32; ++kk) { const float wv = wp[(size_t)kk * MODW];
#pragma unroll
            for (int b = 0; b < 8; ++b) acc[b] += cond[b * 1024 + k0 + kk] * wv; }
#pragma unroll
        for (int b = 0; b < 8; ++b) red[(wave * 8 + b) * 64 + lane] = acc[b];
        __syncthreads();
        { const int b = tid >> 6; float s = 0.f;
#pragma unroll
          for (int w = 0; w < 8; ++w) s += red[(w * 8 + b) * 64 + lane];
          modp[(size_t)((ks * 2 + i) * 8 + b) * MODW + n0 + lane] = s; }
        __syncthreads();
    }
    LAS float* scr = (LAS float*)(lds + wave * 16384);
    const int gw = bid * 8 + wave, NGW = G * 8;
    constexpr int I0 = 16 * 161, I1 = 32 * 32, I2 = 16 * 128, I4 = 64 * 32, I6 = 16 * 96, I7 = 16 * 32;
    constexpr int NITEMS = I0 + I1 + 2 * I2 + 2 * I4 + I6 + I7;
    for (int it = gw; it < NITEMS; it += NGW) {
        int r = it;
        if (r < I0) { transpose_item(a.in[I_SSDIN], D, NIN, (bf16*)(ws + WS_WIN), scr, r, lane); continue; } r -= I0;
        if (r < I1) { transpose_item(a.in[I_SSDOUT], DIN, D, (bf16*)(ws + WS_WOUT), scr, r, lane); continue; } r -= I1;
        if (r < I2) { transpose_item(a.in[I_UP], D, DFF, (bf16*)(ws + WS_WUP0), scr, r, lane); continue; } r -= I2;
        if (r < I2) { transpose_item(a.in[I_UP] + (size_t)D * DFF, D, DFF, (bf16*)(ws + WS_WUP1), scr, r, lane); continue; } r -= I2;
        if (r < I4) { transpose_item(a.in[I_DOWN], DFF, D, (bf16*)(ws + WS_WDN0), scr, r, lane); continue; } r -= I4;
        if (r < I4) { transpose_item(a.in[I_DOWN] + (size_t)D * DFF, DFF, D, (bf16*)(ws + WS_WDN1), scr, r, lane); continue; } r -= I4;
        if (r < I6) { transpose_item(a.in[I_SCIN], D, 3 * D, (bf16*)(ws + WS_WSCIN), scr, r, lane); continue; } r -= I6;
        transpose_item(a.in[I_SCOUT], D, D, (bf16*)(ws + WS_WSCOUT), scr, r, lane);
    }
}

template <bool PART>
__device__ __forceinline__ void norm_phase(const Args& a, LAS unsigned char* lds, const float* src, const float* gw, int layer, int off_sh, int off_sc, bf16* dst,
                                           int bid, int G, int tid, int lane, int wave) {
    LAS float* Aw = (LAS float*)lds; LAS float* Sw = (LAS float*)(lds + 4096);
    const float* modp = (const float*)(a.ws + WS_MODP); const float* mod = (const float*)(a.ws + WS_MOD);
    for (int ck = bid; ck < 256; ck += G) {
        const int row0 = ck * 64, b = row0 >> 11;
        __syncthreads();
        for (int k = tid; k < 1024; k += 512) {
            float sc, sh;
            if (PART) { sc = a.in[I_ADAB][layer * MODW + off_sc + k]; sh = a.in[I_ADAB][layer * MODW + off_sh + k];
#pragma unroll
                for (int ks = 0; ks < 4; ++ks) { const float* p = modp + (size_t)((ks * 2 + layer) * 8 + b) * MODW; sc += p[off_sc + k]; sh += p[off_sh + k]; } }
            else { const float* p = mod + (size_t)(layer * 8 + b) * MODW; sc = p[off_sc + k]; sh = p[off_sh + k]; }
            Aw[k] = gw[k] * (1.0f + sc); Sw[k] = sh; }
        __syncthreads();
        for (int rr = wave; rr < 64; rr += 8) {
            const int row = row0 + rr;
            const f32x4* xr = (const f32x4*)(src + (size_t)row * D) + lane;
            f32x4 v[4]; float s = 0.f;
#pragma unroll
            for (int j = 0; j < 4; ++j) { v[j] = xr[64 * j]; s += (v[j].x * v[j].x + v[j].y * v[j].y) + (v[j].z * v[j].z + v[j].w * v[j].w); }
            const float rstd = __builtin_amdgcn_rsqf(wave_sum(s) * (1.f / D) + EPS);
            u32x2* o8 = (u32x2*)(dst + (size_t)row * D) + lane;
#pragma unroll
            for (int j = 0; j < 4; ++j) { const f32x4 aw = *(const LAS f32x4*)(Aw + 4 * lane + 256 * j), sw = *(const LAS f32x4*)(Sw + 4 * lane + 256 * j);
                const f32x4 o = v[j] * rstd * aw + sw; u32x2 w; w.x = pk2(o.x, o.y); w.y = pk2(o.z, o.w); o8[64 * j] = w; }
        }
    }
}
__device__ __forceinline__ void mod_finalize(const Args& a, int bid, int G, int tid) {
    const float* modp = (const float*)(a.ws + WS_MODP); float* mod = (float*)(a.ws + WS_MOD);
    for (int idx = bid * 512 + tid; idx < 2 * 8 * MODW; idx += G * 512) {
        const int i = idx / (8 * MODW), rem = idx % (8 * MODW), j = rem % MODW;
        float v = a.in[I_ADAB][i * MODW + j];
#pragma unroll
        for (int ks = 0; ks < 4; ++ks) v += modp[(size_t)(ks * 2 + i) * (8 * MODW) + rem];
        mod[idx] = v; }
}

__device__ __forceinline__ void dt_phase(const Args& a, int bid, int G, int lane, int wave) {
    const bf16* H = (const bf16*)(a.ws + WS_H); const bf16* WT = (const bf16*)(a.ws + WS_WIN); float* DT = (float*)(a.ws + WS_DT);
    const int fr = lane & 15, fq = lane >> 4;
    const f32x4 bias0 = *(const f32x4*)(a.in[I_DTB] + 4 * fq), bias1 = *(const f32x4*)(a.in[I_DTB] + 16 + 4 * fq);
    for (int it = bid * 8 + wave; it < M / 16; it += G * 8) {
        const int m0 = it * 16;
        const bf16* ap = H + (size_t)(m0 + fr) * D + 8 * fq;
        const bf16* bp0 = WT + (size_t)(5120 + fr) * D + 8 * fq; const bf16* bp1 = bp0 + (size_t)16 * D;
        f32x4 acc0 = {0.f, 0.f, 0.f, 0.f}, acc1 = {0.f, 0.f, 0.f, 0.f};
#pragma unroll 4
        for (int k0 = 0; k0 < D; k0 += 32) {
            const bf16x8 av = *(const bf16x8*)(ap + k0), b0 = *(const bf16x8*)(bp0 + k0), b1 = *(const bf16x8*)(bp1 + k0);
            acc0 = __builtin_amdgcn_mfma_f32_16x16x32_bf16(b0, av, acc0, 0, 0, 0);
            acc1 = __builtin_amdgcn_mfma_f32_16x16x32_bf16(b1, av, acc1, 0, 0, 0); }
        f32x4 o0, o1;
#pragma unroll
        for (int j = 0; j < 4; ++j) { const float x0 = acc0[j] + bias0[j], x1 = acc1[j] + bias1[j];
            o0[j] = fmaxf(x0, 0.f) + log1pf(expf(-fabsf(x0))); o1[j] = fmaxf(x1, 0.f) + log1pf(expf(-fabsf(x1))); }
        *(f32x4*)(DT + (size_t)(m0 + fr) * NH + 4 * fq) = o0; *(f32x4*)(DT + (size_t)(m0 + fr) * NH + 16 + 4 * fq) = o1;
    }
}
constexpr int RSB = 272;
constexpr int S_BM = 0, S_CM = 34816, S_BDT = 69632, S_XDT = 104448, S_ST = 121856, S_ACS = 139264, S_DTV = 139776, S_CW = 140288;
static_assert(S_CW + 5 * 320 * 4 <= LDS_BYTES, "SSD LDS map");
__device__ __forceinline__ float wave_scan_incl(float v, int lane) {
#pragma unroll
    for (int o = 1; o < 64; o <<= 1) { const float t = __shfl_up(v, o); if (lane >= o) v += t; }
    return v;
}
template <int NR>
__device__ __forceinline__ void conv_col(const u32x4 (&raw)[NR + 3], int j, const LAS float* cw, float (&o)[NR]) {
    float rf[NR + 3];
#pragma unroll
    for (int i = 0; i < NR + 3; ++i) { const unsigned w = raw[i][j >> 1]; rf[i] = (j & 1) ? bfhi(w) : bflo(w); }
    const float w0 = cw[j], w1 = cw[320 + j], w2 = cw[640 + j], w3 = cw[960 + j], bb = cw[1280 + j];
#pragma unroll
    for (int i = 0; i < NR; ++i) o[i] = silu_f(bb + w0 * rf[i] + w1 * rf[i + 1] + w2 * rf[i + 2] + w3 * rf[i + 3]);
}
__device__ __forceinline__ void ssd_phase(const Args& a, LAS unsigned char* lds, int bid, int G, int tid, int lane, int wave) {
    const bf16* XBC = (const bf16*)(a.ws + WS_XBC); bf16* Z = (bf16*)(a.ws + WS_Z); const float* DT = (const float*)(a.ws + WS_DT); float* SS = (float*)(a.ws + WS_SS);
    const int fr = lane & 15, fq = lane >> 4;
    LAS float* Acs = (LAS float*)(lds + S_ACS); LAS float* dtv = (LAS float*)(lds + S_DTV); LAS float* CW = (LAS float*)(lds + S_CW);
    for (int item = bid; item < 256; item += G) {
        const int xcd = item & 7, jj = item >> 3, pg = xcd * 4 + (jj >> 3), hh = jj & 7, b = pg >> 2, g = pg & 3, h = g * 8 + hh;
        const float A_h = -expf(a.in[I_ALOG][h]), D_h = a.in[I_DSK][h];
        __syncthreads();
        for (int i = tid; i < 5 * 320; i += 512) { const int k = i / 320, cl = i % 320;
            const int ch = cl < 64 ? h * 64 + cl : (cl < 192 ? 2048 + g * 128 + (cl - 64) : 2560 + g * 128 + (cl - 192));
            CW[i] = (k < 4) ? a.in[I_SSDCW][k * NCV + ch] : a.in[I_SSDCB][ch]; }
        for (int i = tid; i < 17408 / 4; i += 512) ((LAS unsigned*)(lds + S_ST))[i] = 0u;
        f32x4 sacc[4];
#pragma unroll
        for (int pb = 0; pb < 4; ++pb) sacc[pb] = (f32x4){0.f, 0.f, 0.f, 0.f};
        __syncthreads();
        for (int c = 0; c < 16; ++c) {
            const int t0 = b * SEQ + c * 128;
            if (wave < 2) {
                const float d0 = DT[(size_t)(t0 + lane) * NH + h];
                const float s0 = wave_scan_incl(d0 * A_h, lane);
                if (wave == 0) { Acs[lane] = s0; dtv[lane] = d0; }
                else { const float tot0 = __shfl(s0, 63); const float d1 = DT[(size_t)(t0 + 64 + lane) * NH + h];
                       const float s1 = wave_scan_incl(d1 * A_h, lane); Acs[64 + lane] = s1 + tot0; dtv[64 + lane] = d1; }
            }
            {
                const int cgp = tid & 15, rs = tid >> 4;
                const bf16* src = XBC + (ptrdiff_t)(t0 + 4 * rs - 3) * NCV + 2560 + g * 128 + 8 * cgp;
                u32x4 raw[7];
#pragma unroll
                for (int i = 0; i < 7; ++i) { const bool ok = (c > 0) || (4 * rs - 3 + i >= 0); raw[i] = ok ? *(const u32x4*)(src + (ptrdiff_t)i * NCV) : (u32x4){0u, 0u, 0u, 0u}; }
                unsigned pk[4][4];
#pragma unroll
                for (int j2 = 0; j2 < 4; ++j2) { float oa[4], ob[4]; conv_col<4>(raw, 2 * j2, CW + 192 + 8 * cgp, oa); conv_col<4>(raw, 2 * j2 + 1, CW + 192 + 8 * cgp, ob);
#pragma unroll
                    for (int i = 0; i < 4; ++i) pk[i][j2] = pk2(oa[i], ob[i]); }
#pragma unroll
                for (int i = 0; i < 4; ++i) *(LAS u32x4*)(lds + S_CM + (4 * rs + i) * RSB + cgp * 16) = (u32x4){pk[i][0], pk[i][1], pk[i][2], pk[i][3]};
            }
            __syncthreads();
            {
                const int cgp = tid & 15, rs = tid >> 4;
                const bf16* src = XBC + (ptrdiff_t)(t0 + 4 * rs - 3) * NCV + 2048 + g * 128 + 8 * cgp;
                u32x4 raw[7];
#pragma unroll
                for (int i = 0; i < 7; ++i) { const bool ok = (c > 0) || (4 * rs - 3 + i >= 0); raw[i] = ok ? *(const u32x4*)(src + (ptrdiff_t)i * NCV) : (u32x4){0u, 0u, 0u, 0u}; }
                const float alast = Acs[127]; const f32x4 as4 = *(const LAS f32x4*)(Acs + 4 * rs);
                float E[4];
#pragma unroll
                for (int i = 0; i < 4; ++i) E[i] = fexp(alast - as4[i]);
                unsigned pk[4][4];
#pragma unroll
                for (int j2 = 0; j2 < 4; ++j2) { float oa[4], ob[4]; conv_col<4>(raw, 2 * j2, CW + 64 + 8 * cgp, oa); conv_col<4>(raw, 2 * j2 + 1, CW + 64 + 8 * cgp, ob);
#pragma unroll
                    for (int i = 0; i < 4; ++i) pk[i][j2] = pk2(oa[i], ob[i]);
                    *(LAS u32x2*)(lds + S_BDT + (8 * cgp + 2 * j2) * RSB + rs * 8) = (u32x2){pk2(oa[0] * E[0], oa[1] * E[1]), pk2(oa[2] * E[2], oa[3] * E[3])};
                    *(LAS u32x2*)(lds + S_BDT + (8 * cgp + 2 * j2 + 1) * RSB + rs * 8) = (u32x2){pk2(ob[0] * E[0], ob[1] * E[1]), pk2(ob[2] * E[2], ob[3] * E[3])}; }
#pragma unroll
                for (int i = 0; i < 4; ++i) *(LAS u32x4*)(lds + S_BM + (4 * rs + i) * RSB + cgp * 16) = (u32x4){pk[i][0], pk[i][1], pk[i][2], pk[i][3]};
            }
            {
                const int cgp = tid & 7, rs = tid >> 3;
                const bf16* src = XBC + (ptrdiff_t)(t0 + 2 * rs - 3) * NCV + h * 64 + 8 * cgp;
                u32x4 raw[5];
#pragma unroll
                for (int i = 0; i < 5; ++i) { const bool ok = (c > 0) || (2 * rs - 3 + i >= 0); raw[i] = ok ? *(const u32x4*)(src + (ptrdiff_t)i * NCV) : (u32x4){0u, 0u, 0u, 0u}; }
                const float d0 = dtv[2 * rs], d1 = dtv[2 * rs + 1];
#pragma unroll
                for (int j = 0; j < 8; ++j) { float o[2]; conv_col<2>(raw, j, CW + 8 * cgp, o);
                    *(LAS unsigned*)(lds + S_XDT + (8 * cgp + j) * RSB + rs * 4) = pk2(o[0] * d0, o[1] * d1); }
            }
            __syncthreads();
            bf16x8 Cf[4];
#pragma unroll
            for (int kk = 0; kk < 4; ++kk) Cf[kk] = *(const LAS bf16x8*)(lds + S_CM + (16 * wave + fr) * RSB + (32 * kk + 8 * fq) * 2);
            unsigned Mw[4][4];
#pragma unroll
            for (int kb = 0; kb < 4; ++kb)
#pragma unroll
                for (int e = 0; e < 4; ++e) Mw[kb][e] = 0u;
            const float acs_l = Acs[16 * wave + fr]; const int lidx = 16 * wave + fr;
#pragma unroll
            for (int sb = 0; sb < 8; ++sb) {
                if (sb <= wave) {
                    f32x4 s = {0.f, 0.f, 0.f, 0.f};
#pragma unroll
                    for (int kk = 0; kk < 4; ++kk) { const bf16x8 af = *(const LAS bf16x8*)(lds + S_BM + (16 * sb + fr) * RSB + (32 * kk + 8 * fq) * 2);
                        s = __builtin_amdgcn_mfma_f32_16x16x32_bf16(af, Cf[kk], s, 0, 0, 0); }
                    const f32x4 as4 = *(const LAS f32x4*)(Acs + 16 * sb + 4 * fq);
                    float v[4];
#pragma unroll
                    for (int i = 0; i < 4; ++i) { const int sidx = 16 * sb + 4 * fq + i; const float e = fexp(fminf(acs_l - as4[i], 0.f)); v[i] = (sidx <= lidx) ? s[i] * e : 0.f; }
                    Mw[sb >> 1][(sb & 1) * 2 + 0] = pk2(v[0], v[1]); Mw[sb >> 1][(sb & 1) * 2 + 1] = pk2(v[2], v[3]);
                }
            }
            f32x4 yd[4], yo[4];
#pragma unroll
            for (int pb = 0; pb < 4; ++pb) { yd[pb] = (f32x4){0.f, 0.f, 0.f, 0.f}; yo[pb] = (f32x4){0.f, 0.f, 0.f, 0.f}; }
#pragma unroll
            for (int kb = 0; kb < 4; ++kb) {
                if (2 * kb <= wave) {
                    const u32x4 mw = {Mw[kb][0], Mw[kb][1], Mw[kb][2], Mw[kb][3]}; const bf16x8 mf = __builtin_bit_cast(bf16x8, mw);
#pragma unroll
                    for (int pb = 0; pb < 4; ++pb) { const u32x2 lo = *(const LAS u32x2*)(lds + S_XDT + (16 * pb + fr) * RSB + (32 * kb + 4 * fq) * 2);
                        const u32x2 hi = *(const LAS u32x2*)(lds + S_XDT + (16 * pb + fr) * RSB + (32 * kb + 16 + 4 * fq) * 2);
                        const u32x4 xw = {lo.x, lo.y, hi.x, hi.y};
                        yd[pb] = __builtin_amdgcn_mfma_f32_16x16x32_bf16(mf, __builtin_bit_cast(bf16x8, xw), yd[pb], 0, 0, 0); }
                }
            }
            if (c > 0) {
#pragma unroll
                for (int kk = 0; kk < 4; ++kk)
#pragma unroll
                    for (int pb = 0; pb < 4; ++pb) { const bf16x8 sf = *(const LAS bf16x8*)(lds + S_ST + (16 * pb + fr) * RSB + (32 * kk + 8 * fq) * 2);
                        yo[pb] = __builtin_amdgcn_mfma_f32_16x16x32_bf16(Cf[kk], sf, yo[pb], 0, 0, 0); }
            }
            {
                const f32x4 al4 = *(const LAS f32x4*)(Acs + 16 * wave + 4 * fq), dt4 = *(const LAS f32x4*)(dtv + 16 * wave + 4 * fq);
                float ea[4], rdt[4], ssq[4];
#pragma unroll
                for (int i = 0; i < 4; ++i) { ea[i] = fexp(al4[i]); rdt[i] = 1.0f / dt4[i]; ssq[i] = 0.f; }
#pragma unroll
                for (int pb = 0; pb < 4; ++pb) {
                    const u32x2 xd = *(const LAS u32x2*)(lds + S_XDT + (16 * pb + fr) * RSB + (16 * wave + 4 * fq) * 2);
                    const float xv[4] = {bflo(xd.x), bfhi(xd.x), bflo(xd.y), bfhi(xd.y)};
#pragma unroll
                    for (int i = 0; i < 4; ++i) {
                        bf16* zp = Z + (size_t)(t0 + 16 * wave + 4 * fq + i) * DIN + h * 64 + 16 * pb + fr;
                        const float z = bf1(*zp);
                        const float y = yd[pb][i] + ea[i] * yo[pb][i] + D_h * xv[i] * rdt[i];
                        const float yz = y * silu_f(z);
                        *zp = (bf16)(pk2(yz, 0.f) & 0xffffu); ssq[i] += yz * yz;
                    }
                }
#pragma unroll
                for (int i = 0; i < 4; ++i) { float s = ssq[i]; s += __shfl_xor(s, 1); s += __shfl_xor(s, 2); s += __shfl_xor(s, 4); s += __shfl_xor(s, 8);
                    if (fr == 0) SS[(size_t)(t0 + 16 * wave + 4 * fq + i) * NH + h] = s; }
            }
            if (c < 15) {
                const float dec = fexp(Acs[127]);
#pragma unroll
                for (int pb = 0; pb < 4; ++pb) sacc[pb] = sacc[pb] * dec;
#pragma unroll
                for (int ks = 0; ks < 4; ++ks) { const bf16x8 bfr = *(const LAS bf16x8*)(lds + S_BDT + (16 * wave + fr) * RSB + (32 * ks + 8 * fq) * 2);
#pragma unroll
                    for (int pb = 0; pb < 4; ++pb) { const bf16x8 xf = *(const LAS bf16x8*)(lds + S_XDT + (16 * pb + fr) * RSB + (32 * ks + 8 * fq) * 2);
                        sacc[pb] = __builtin_amdgcn_mfma_f32_16x16x32_bf16(bfr, xf, sacc[pb], 0, 0, 0); } }
            }
            __syncthreads();
            if (c < 15) {
#pragma unroll
                for (int pb = 0; pb < 4; ++pb) *(LAS u32x2*)(lds + S_ST + (16 * pb + fr) * RSB + (16 * wave + 4 * fq) * 2) = (u32x2){pk2(sacc[pb][0], sacc[pb][1]), pk2(sacc[pb][2], sacc[pb][3])};
            }
        }
    }
}

__device__ __forceinline__ void gnorm_phase(const Args& a, int bid, int G, int lane, int wave) {
    bf16* YZ = (bf16*)(a.ws + WS_Z); const float* SS = (const float*)(a.ws + WS_SS); const float* nw = a.in[I_SSDNW];
    for (int row = bid * 8 + wave; row < M; row += G * 8) {
#pragma unroll
        for (int g = 0; g < 4; ++g) {
            u32x4* p = (u32x4*)(YZ + (size_t)row * DIN + g * 512 + lane * 8);
            const u32x4 v = *p;
            float s = SS[(size_t)row * NH + g * 8 + (lane & 7)]; s += __shfl_xor(s, 1); s += __shfl_xor(s, 2); s += __shfl_xor(s, 4);
            const float rs = __builtin_amdgcn_rsqf(s * (1.0f / 512.0f) + EPS);
            const f32x4 w0 = *(const f32x4*)(nw + g * 512 + lane * 8), w1 = *(const f32x4*)(nw + g * 512 + lane * 8 + 4);
            u32x4 o; o.x = pk2(bflo(v.x) * rs * w0.x, bfhi(v.x) * rs * w0.y); o.y = pk2(bflo(v.y) * rs * w0.z, bfhi(v.y) * rs * w0.w);
            o.z = pk2(bflo(v.z) * rs * w1.x, bfhi(v.z) * rs * w1.y); o.w = pk2(bflo(v.w) * rs * w1.z, bfhi(v.w) * rs * w1.w);
            *p = o;
        }
    }
}

__device__ __forceinline__ void sconv_phase(const Args& a, int bid, int G, int lane, int wave) {
    const bf16* P = (const bf16*)(a.ws + WS_PROJ); bf16* Y = (bf16*)(a.ws + WS_YSC); const float* cw = a.in[I_SCCW];
    for (int it = bid * 8 + wave; it < 2048; it += G * 8) {
        const int seg = it >> 1, col = (it & 1) * 512 + lane * 8, row0 = seg * 16;
        float w[3][8];
#pragma unroll
        for (int k = 0; k < 3; ++k) { const f32x4 a0 = *(const f32x4*)(cw + k * D + col), a1 = *(const f32x4*)(cw + k * D + col + 4);
            w[k][0] = a0.x; w[k][1] = a0.y; w[k][2] = a0.z; w[k][3] = a0.w; w[k][4] = a1.x; w[k][5] = a1.y; w[k][6] = a1.z; w[k][7] = a1.w; }
        float u2[8], u1[8];
#pragma unroll
        for (int j = 0; j < 8; ++j) { u2[j] = 0.f; u1[j] = 0.f; }
        if ((row0 & (SEQ - 1)) != 0) {
            const u32x4 c2 = *(const u32x4*)(P + (size_t)(row0 - 2) * NCV + D + col), x2 = *(const u32x4*)(P + (size_t)(row0 - 2) * NCV + 2 * D + col);
            const u32x4 c1 = *(const u32x4*)(P + (size_t)(row0 - 1) * NCV + D + col), x1 = *(const u32x4*)(P + (size_t)(row0 - 1) * NCV + 2 * D + col);
#pragma unroll
            for (int q = 0; q < 4; ++q) { u2[2 * q] = bflo(c2[q]) * bflo(x2[q]); u2[2 * q + 1] = bfhi(c2[q]) * bfhi(x2[q]); u1[2 * q] = bflo(c1[q]) * bflo(x1[q]); u1[2 * q + 1] = bfhi(c1[q]) * bfhi(x1[q]); }
        }
#pragma unroll 4
        for (int r = 0; r < 16; ++r) {
            const bf16* rp = P + (size_t)(row0 + r) * NCV + col;
            const u32x4 bg = *(const u32x4*)rp, cv = *(const u32x4*)(rp + D), xv = *(const u32x4*)(rp + 2 * D);
            float u0[8], y[8];
#pragma unroll
            for (int q = 0; q < 4; ++q) { u0[2 * q] = bflo(cv[q]) * bflo(xv[q]); u0[2 * q + 1] = bfhi(cv[q]) * bfhi(xv[q]); }
#pragma unroll
            for (int j = 0; j < 8; ++j) { const float bgv = (j & 1) ? bfhi(bg[j >> 1]) : bflo(bg[j >> 1]); y[j] = bgv * (w[0][j] * u2[j] + w[1][j] * u1[j] + w[2][j] * u0[j]); u2[j] = u1[j]; u1[j] = u0[j]; }
            *(u32x4*)(Y + (size_t)(row0 + r) * D + col) = (u32x4){pk2(y[0], y[1]), pk2(y[2], y[3]), pk2(y[4], y[5]), pk2(y[6], y[7])};
        }
    }
}

__device__ __forceinline__ void fnorm_phase(const Args& a, int bid, int G, int lane, int wave) {
    const float* gw = a.in[I_FNW];
    for (int row = bid * 8 + wave; row < M; row += G * 8) {
        f32x4* xr = (f32x4*)(a.out + (size_t)row * D) + lane;
        f32x4 v[4]; float s = 0.f;
#pragma unroll
        for (int j = 0; j < 4; ++j) { v[j] = xr[64 * j]; s += (v[j].x * v[j].x + v[j].y * v[j].y) + (v[j].z * v[j].z + v[j].w * v[j].w); }
        const float rstd = __builtin_amdgcn_rsqf(wave_sum(s) * (1.f / D) + EPS);
#pragma unroll
        for (int j = 0; j < 4; ++j) { const f32x4 w = *(const f32x4*)(gw + 4 * lane + 256 * j); xr[64 * j] = v[j] * rstd * w; }
    }
}


#define XB_TMO      128
#define XB_XCNT(j)  (256  + 64 * (j))
#define XB_XSUB(j)  (1280 + 64 * (j))
#define XB_XGEN(j)  (2304 + 64 * (j))
#define XB_TOP      3328
#define XB_TOPGEN   3392
#define XCD_BAR_WORDS 3456
#define XB_SPIN_CAP (1u << 18)

__device__ __forceinline__ unsigned xb_ld(unsigned* p)              { return __hip_atomic_load(p, __ATOMIC_RELAXED, __HIP_MEMORY_SCOPE_AGENT); }
__device__ __forceinline__ unsigned xb_add(unsigned* p, unsigned v) { return __hip_atomic_fetch_add(p, v, __ATOMIC_RELAXED, __HIP_MEMORY_SCOPE_AGENT); }
__device__ __forceinline__ unsigned xb_xcc_id() { return (unsigned)__builtin_amdgcn_s_getreg((3 << 11) | 20) & 0xFu; }
#define XB_SPIN(cond, bar) do { unsigned _sp = 0; while (cond) { __builtin_amdgcn_s_sleep(1); \
    if ((++_sp & 255u) == 0u) { if (xb_ld(&(bar)[XB_TMO])) break; if (_sp > XB_SPIN_CAP) { atomicAdd(&(bar)[XB_TMO], 1u); break; } } } } while (0)

struct XcdBarrier {
    unsigned* bar; unsigned x;
    volatile LAS unsigned* st;
};

__device__ __forceinline__ XcdBarrier xcd_barrier_post(unsigned* bar, volatile LAS unsigned* st) {
    XcdBarrier b; b.bar = bar; b.x = xb_xcc_id(); b.st = st;
    if (threadIdx.x == 0) (void)xb_add(&bar[XB_XCNT(b.x)], 1u);
    return b;
}
__device__ __forceinline__ void xcd_barrier_complete(unsigned* bar, unsigned x, unsigned& nloc, unsigned& nx) {
    const unsigned G = gridDim.x * gridDim.y * gridDim.z;
    unsigned sum, cnt, mine, sp = 0u;
    for (;;) {
        sum = 0u; cnt = 0u; mine = 0u;
#pragma unroll
        for (unsigned j = 0; j < 16; ++j) { const unsigned c = xb_ld(&bar[XB_XCNT(j)]); sum += c; cnt += (c > 0u) ? 1u : 0u; mine = (j == x) ? c : mine; }
        if (sum == G) break;
        __builtin_amdgcn_s_sleep(1);
        if ((++sp & 255u) == 0u) { if (xb_ld(&bar[XB_TMO])) break; if (sp > XB_SPIN_CAP) { atomicAdd(&bar[XB_TMO], 1u); break; } }
    }
    nloc = mine > 0u ? mine : 1u; nx = cnt > 0u ? cnt : 1u;
}

__device__ __forceinline__ void xcd_barrier(const XcdBarrier& b) {
    asm volatile("s_waitcnt vmcnt(0)" ::: "memory");
    __syncthreads();
    if (threadIdx.x == 0) {
        unsigned* bar = b.bar;
        __builtin_amdgcn_s_waitcnt(0);
        unsigned nloc = b.st[0], nx = b.st[1];
        if (nloc == 0u) { xcd_barrier_complete(bar, b.x, nloc, nx); b.st[0] = nloc; b.st[1] = nx; }
        const unsigned old = xb_add(&bar[XB_XSUB(b.x)], 1u);
        const unsigned gen = old / nloc;
        if (old + 1u == (gen + 1u) * nloc) {
            __builtin_amdgcn_fence(__ATOMIC_RELEASE, "agent");
            asm volatile("s_waitcnt vmcnt(0)" ::: "memory");
            const unsigned og = xb_add(&bar[XB_TOP], 1u);
            const unsigned tg = og / nx;
            if (og + 1u == (tg + 1u) * nx) xb_add(&bar[XB_TOPGEN], 1u);
            else XB_SPIN(xb_ld(&bar[XB_TOPGEN]) == tg, bar);
            __builtin_amdgcn_fence(__ATOMIC_ACQUIRE, "agent");
            xb_add(&bar[XB_XGEN(b.x)], 1u);
            asm volatile("s_waitcnt vmcnt(0)" ::: "memory");
        } else {
            XB_SPIN(xb_ld(&bar[XB_XGEN(b.x)]) == gen, bar);
            __builtin_amdgcn_fence(__ATOMIC_ACQUIRE, "agent");
            asm volatile("s_waitcnt vmcnt(0)" ::: "memory");
        }
    }
    __syncthreads();
}

#ifndef AMP_MASK
#define AMP_MASK 0
#endif
#ifndef AMP_K
#define AMP_K 1
#endif
#ifndef SYNC_REP
#define SYNC_REP 1
#endif
#define PH(id, ...) do { if ((AMP_MASK >> (id)) & 1) { const unsigned long long _t0 = __builtin_amdgcn_s_memrealtime(); __VA_ARGS__; __syncthreads(); \
    const unsigned long long _el = __builtin_amdgcn_s_memrealtime() - _t0; while (__builtin_amdgcn_s_memrealtime() - _t0 < _el * (1 + AMP_K)) __builtin_amdgcn_s_sleep(8); } else { __VA_ARGS__; } } while (0)
__device__ __forceinline__ void gsync_cg(cg::grid_group& grid) {
    asm volatile("s_waitcnt vmcnt(0) lgkmcnt(0)" ::: "memory");
    __threadfence();
    grid.sync();
    __threadfence();
}
#define gsync(grid) xcd_barrier(xbar)
template <class Epi>
__device__ __forceinline__ void run_gemm(LAS unsigned char* lds, const bf16* A, const bf16* Bt, int N, int K, const Epi& E, int G, int bid) {
    pg8::Gemm g{A, Bt, M, N, K}; pg8::StaticOrder S; S.init(M, N, G, bid);
    pg8::gemm_phase<Epi, pg8::StaticOrder, true, true>(lds, g, S, E);
}

__global__ void __launch_bounds__(512, 2) mk_fwd(Args a) {
    extern __shared__ __attribute__((aligned(16))) unsigned char lds_raw[];
    LAS unsigned char* lds = (LAS unsigned char*)lds_raw;
    cg::grid_group grid = cg::this_grid();
    const int tid = threadIdx.x, lane = tid & 63, wave = __builtin_amdgcn_readfirstlane(tid >> 6), bid = blockIdx.x, G = gridDim.x;
    unsigned char* ws = a.ws;
    bf16* H = (bf16*)(ws + WS_H);
    const float* MOD = (const float*)(ws + WS_MOD);

    if (bid == 0) for (int i = tid; i < XCD_BAR_WORDS; i += 512) ((unsigned*)ws)[i] = 0u;
    if (tid < 16) ((volatile LAS unsigned*)(lds + LDS_BYTES - 64))[tid] = 0u;
    PH(0, p0_phase(a, lds, bid, G, tid, lane, wave));
    gsync_cg(grid);
    XcdBarrier xbar = xcd_barrier_post((unsigned*)ws, (volatile LAS unsigned*)(lds + LDS_BYTES - 64));
    mod_finalize(a, bid, G, tid);
    PH(1, norm_phase<true>(a, lds, a.in[I_X], a.in[I_MIXNW], 0, 0, 1024, H, bid, G, tid, lane, wave));
    gsync(grid);
    { pg8::EpiBf16S<0> E{(bf16*)(ws + WS_Z), DIN, (bf16*)(ws + WS_XBC), NCV, DIN};
      PH(2, run_gemm(lds, H, (const bf16*)(ws + WS_WIN), 5120, D, E, G, bid)); }
    PH(4, dt_phase(a, bid, G, lane, wave));
    gsync(grid);
    PH(3, ssd_phase(a, lds, bid, G, tid, lane, wave));
    gsync(grid);
    PH(1, gnorm_phase(a, bid, G, lane, wave));
    gsync(grid);
    { pg8::EpiRes E{a.in[I_X], a.out, MOD + 2048};
      PH(2, run_gemm(lds, (const bf16*)(ws + WS_Z), (const bf16*)(ws + WS_WOUT), D, DIN, E, G, bid)); }
    gsync(grid);
    PH(1, norm_phase<false>(a, lds, a.out, a.in[I_MLPNW], 0, 3072, 4096, H, bid, G, tid, lane, wave));
    gsync(grid);
    { pg8::EpiBf16S<2> E{(bf16*)(ws + WS_ACT), DFF, (bf16*)(ws + WS_ACT), DFF, 1 << 30};
      PH(2, run_gemm(lds, H, (const bf16*)(ws + WS_WUP0), DFF, D, E, G, bid)); }
    gsync(grid);
    { pg8::EpiRes E{a.out, a.out, MOD + 5120};
      PH(2, run_gemm(lds, (const bf16*)(ws + WS_ACT), (const bf16*)(ws + WS_WDN0), D, DFF, E, G, bid)); }
    gsync(grid);
    PH(1, norm_phase<false>(a, lds, a.out, a.in[I_MIXNW] + D, 1, 0, 1024, H, bid, G, tid, lane, wave));
    gsync(grid);
    { pg8::EpiBf16S<0> E{(bf16*)(ws + WS_PROJ), NCV, (bf16*)(ws + WS_PROJ), NCV, 1 << 30};
      PH(2, run_gemm(lds, H, (const bf16*)(ws + WS_WSCIN), NCV, D, E, G, bid)); }
    gsync(grid);
    PH(1, sconv_phase(a, bid, G, lane, wave));
    gsync(grid);
    { pg8::EpiRes E{a.out, a.out, MOD + 8 * MODW + 2048};
      PH(2, run_gemm(lds, (const bf16*)(ws + WS_YSC), (const bf16*)(ws + WS_WSCOUT), D, D, E, G, bid)); }
    gsync(grid);
    PH(1, norm_phase<false>(a, lds, a.out, a.in[I_MLPNW] + D, 1, 3072, 4096, H, bid, G, tid, lane, wave));
    gsync(grid);
    { pg8::EpiBf16S<2> E{(bf16*)(ws + WS_ACT), DFF, (bf16*)(ws + WS_ACT), DFF, 1 << 30};
      PH(2, run_gemm(lds, H, (const bf16*)(ws + WS_WUP1), DFF, D, E, G, bid)); }
    gsync(grid);
    { pg8::EpiRes E{a.out, a.out, MOD + 8 * MODW + 5120};
      PH(2, run_gemm(lds, (const bf16*)(ws + WS_ACT), (const bf16*)(ws + WS_WDN1), D, DFF, E, G, bid)); }
    gsync(grid);
    PH(1, fnorm_phase(a, bid, G, lane, wave));
}

extern "C" void kernel_launch(void* const* d_in, const int* in_sizes, int n_in, void* d_out, int out_size, void* d_ws, size_t ws_size, hipStream_t stream) {
    static int grid = 0;
    if (grid == 0) {
        if (n_in != 20 || in_sizes[0] != M * D || out_size != M * D || ws_size < WS_END) { fprintf(stderr, "kernel_launch: unexpected shapes (n_in %d, in0 %d, out %d, ws %zu)\n", n_in, n_in > 0 ? in_sizes[0] : -1, out_size, ws_size); grid = -1; return; }
        int dev = 0, cus = 0, per_cu = 0;
        hipGetDevice(&dev); hipDeviceGetAttribute(&cus, hipDeviceAttributeMultiprocessorCount, dev);
        if (hipFuncSetAttribute((const void*)mk_fwd, hipFuncAttributeMaxDynamicSharedMemorySize, LDS_BYTES) != hipSuccess) { fprintf(stderr, "kernel_launch: hipFuncSetAttribute failed\n"); grid = -1; return; }
        if (hipOccupancyMaxActiveBlocksPerMultiprocessor(&per_cu, (const void*)mk_fwd, 512, LDS_BYTES) != hipSuccess || per_cu < 1) { fprintf(stderr, "kernel_launch: occupancy query says %d blocks per CU\n", per_cu); (void)hipGetLastError(); per_cu = 1; }
        grid = cus;
        if (grid <= 0) { grid = -1; return; }
    }
    if (grid < 0) return;
    Args a{};
    for (int i = 0; i < 20; ++i) a.in[i] = (const float*)d_in[i];
    a.out = (float*)d_out; a.ws = (unsigned char*)d_ws;
    void* args[] = {&a};
    hipError_t e = hipLaunchCooperativeKernel((const void*)mk_fwd, dim3(grid), dim3(512), args, LDS_BYTES, stream);
    if (e != hipSuccess) fprintf(stderr, "cooperative launch failed: %s (grid %d)\n", hipGetErrorString(e), grid);
}
```

```cpp
#include <hip/hip_runtime.h>
#include <hip/hip_cooperative_groups.h>
#include <cstdio>
#include <cstdint>
namespace cg = cooperative_groups;
namespace pg8 {
#define PG8_LAS __attribute__((address_space(3)))
typedef unsigned short bf16_t;
typedef short bf16x8 __attribute__((ext_vector_type(8)));
typedef float f32x4 __attribute__((ext_vector_type(4)));
typedef unsigned u32x4 __attribute__((ext_vector_type(4)));
constexpr int BM = 256, BK = 64, HALF = 128, HTB = HALF * BK * 2  , STAGE_BYTES = 8 * HTB, NXCD = 8, WGM = 8;

__host__ __device__ __forceinline__ int lds_byte(int r, int c) { const int st = (r >> 4) * 2 + (c >> 5), rr = r & 15, cc = c & 31, ob = rr * 64 + cc * 2; return st * 1024 + (ob ^ (((ob >> 9) & 1) << 5)); }
__host__ __device__ __forceinline__ void stage_rc(int b, int& R, int& C) { const int st = b / 1024, sb = b % 1024, swz = sb ^ (((sb >> 9) & 1) << 5); R = (st >> 1) * 16 + swz / 64; C = (st & 1) * 32 + (swz % 64) / 2; }
__host__ __device__ __forceinline__ int perm32(int rho) { const int n = rho >> 4, i = rho & 15; return 8 * (i >> 2) + 4 * n + (i & 3); }

struct Unit { int pm, pn; };
struct Gemm { const bf16_t* A; const bf16_t* Bt; int M, N, K; };

struct StaticOrder {
    int nM, nN, nwg, G, c;
    __host__ __device__ void init(int M, int N, int G_, int c_) { nM = M / BM; nN = N / BM; nwg = nM * nN; G = G_; c = c_; }
    __host__ __device__ bool next(int i, Unit& u) const {
        const long L = (long)i * G + c; if (L >= nwg) return false;
        int wgid = (int)L; { const int q = nwg / NXCD, r = nwg % NXCD, xcd = wgid % NXCD, off = wgid / NXCD; wgid = (xcd < r ? xcd * (q + 1) : r * (q + 1) + (xcd - r) * q) + off; }
        const int nig = WGM * nN, gid = wgid / nig, fm = gid * WGM, gsz = (nM - fm) < WGM ? (nM - fm) : WGM;
        u.pm = fm + ((wgid % nig) % gsz); u.pn = (wgid % nig) / gsz; return true;
    }
    __device__ __forceinline__ void a_ready(const Unit&) const {}
    __device__ __forceinline__ void done(const Unit&) const {}
};
__device__ __forceinline__ unsigned cvt_pk_bf16(float lo, float hi) { unsigned r; asm volatile("v_cvt_pk_bf16_f32 %0, %1, %2" : "=v"(r) : "v"(lo), "v"(hi)); return r; }
typedef float f32x2 __attribute__((ext_vector_type(2)));
__device__ __forceinline__ unsigned pk2bf(float lo, float hi) { unsigned r; asm("v_cvt_pk_bf16_f32 %0, %1, %2" : "=v"(r) : "v"(lo), "v"(hi)); return r; }
template <int ACT  > struct EpiBf16S {
    static constexpr bool PERM = true, AFTER_DRAIN = false;
    bf16_t* O0; int ld0; bf16_t* O1; int ld1; int csplit;
    __device__ __forceinline__ void operator()(const f32x4 (&acc)[2][2][4][2], const Unit& u, int wr, int wc, int fr, int fq) const {
        const int row0 = u.pm * BM + wr * 64 + fr; int colt = u.pn * BM; bf16_t* base = O0; int ldc = ld0;
        if (colt >= csplit) { base = O1; ldc = ld1; colt -= csplit; }
        const int col0 = colt + wc * 32 + 8 * fq;
#pragma unroll
        for (int ai = 0; ai < 2; ++ai)
#pragma unroll
            for (int m = 0; m < 4; ++m) { bf16_t* rowp = base + (size_t)(row0 + ai * HALF + m * 16) * ldc + col0;
#pragma unroll
                for (int bj = 0; bj < 2; ++bj) { f32x4 v0 = acc[ai][bj][m][0], v1 = acc[ai][bj][m][1];
                    if (ACT == 2) {
#pragma unroll
                        for (int e = 0; e < 4; ++e) { float a0 = fmaxf(v0[e], 0.f), a1 = fmaxf(v1[e], 0.f); v0[e] = a0 * a0; v1[e] = a1 * a1; } }
                    u32x4 w; w.x = pk2bf(v0[0], v0[1]); w.y = pk2bf(v0[2], v0[3]); w.z = pk2bf(v1[0], v1[1]); w.w = pk2bf(v1[2], v1[3]);
                    *(u32x4*)(rowp + bj * HALF) = w; } }
    }
};
struct EpiRes {
    static constexpr bool PERM = false, AFTER_DRAIN = false;
    const float* base; float* out; const float* gate;
    __device__ __forceinline__ void operator()(const f32x4 (&acc)[2][2][4][2], const Unit& u, int wr, int wc, int fr, int fq) const {
        const int b = (u.pm * BM) >> 11; const float* gp = gate + (size_t)b * 6144;
        const int col0 = u.pn * BM + wc * 32 + 4 * fq;
        f32x4 gv[2][2];
#pragma unroll
        for (int bj = 0; bj < 2; ++bj)
#pragma unroll
            for (int n = 0; n < 2; ++n) gv[bj][n] = *(const f32x4*)(gp + col0 + bj * HALF + n * 16);
#pragma unroll
        for (int ai = 0; ai < 2; ++ai)
#pragma unroll
            for (int m = 0; m < 4; ++m) { const size_t off = (size_t)(u.pm * BM + ai * HALF + wr * 64 + m * 16 + fr) * 1024 + col0;
#pragma unroll
                for (int bj = 0; bj < 2; ++bj)
#pragma unroll
                    for (int n = 0; n < 2; ++n) { const f32x4 bs = *(const f32x4*)(base + off + bj * HALF + n * 16);
                        *(f32x4*)(out + off + bj * HALF + n * 16) = bs + gv[bj][n] * acc[ai][bj][m][n]; }
                asm volatile("" ::: "memory"); }
    }
};

template <class Epi, class Sched, bool ALIGN_EPI = false, bool SP2 = false>
__device__ __forceinline__ void gemm_phase(PG8_LAS unsigned char* lds, const Gemm g, const Sched& S, const Epi& E) {
    const int tid = threadIdx.x, wid = __builtin_amdgcn_readfirstlane(tid >> 6), lane = tid & 63, wr = wid >> 2, wc = wid & 3, fr = lane & 15, fq = lane >> 4;
    const int K = g.K, nt = K / BK;
    unsigned voffA[2], voffB[2];
#pragma unroll
    for (int i = 0; i < 2; ++i) { int R, C; stage_rc(tid * 16 + i * 8192, R, C); const int Rb = Epi::PERM ? ((R & ~31) + perm32(R & 31)) : R;
        voffA[i] = (unsigned)(R * K + C) * 2u; voffB[i] = (unsigned)(Rb * K + C) * 2u; }
    const size_t kstep = (size_t)(BK * 2);
    const size_t hstep = (size_t)HALF * K * 2;
    const size_t tstep = 2 * hstep;
    const unsigned ldsw = (unsigned)wid * 1024u;
    const int aoff = lds_byte(wr * 64 + fr, fq * 8), boff = lds_byte(wc * 32 + fr, fq * 8);
#define PG8_SA(b, h) (((b) * 2 + (h)) * HTB)
#define PG8_SB(b, h) ((4 + (b) * 2 + (h)) * HTB)
#define PG8_STAGE(bufoff, gbase, voff) do { _Pragma("unroll") for (int _i = 0; _i < 2; ++_i) \
        __builtin_amdgcn_global_load_lds((const unsigned*)((const char*)(gbase) + (voff)[_i]), (PG8_LAS unsigned*)(lds + (bufoff) + ldsw + _i * 8192), 16, 0, 0); } while (0)
#define PG8_LDA(dst, b, h) do { _Pragma("unroll") for (int m = 0; m < 4; ++m) _Pragma("unroll") for (int k = 0; k < 2; ++k) dst[m][k] = *(const PG8_LAS bf16x8*)(lds + PG8_SA(b, h) + aoff + m * 2048 + k * 1024); } while (0)
#define PG8_LDB(dst, b, h) do { _Pragma("unroll") for (int n = 0; n < 2; ++n) _Pragma("unroll") for (int k = 0; k < 2; ++k) dst[n][k] = *(const PG8_LAS bf16x8*)(lds + PG8_SB(b, h) + boff + n * 2048 + k * 1024); } while (0)
#define PG8_MMA(ai, bj, At, Bt) do { __builtin_amdgcn_s_setprio(1); _Pragma("unroll") for (int m = 0; m < 4; ++m) _Pragma("unroll") for (int n = 0; n < 2; ++n) _Pragma("unroll") for (int k = 0; k < 2; ++k) \
        acc[ai][bj][m][n] = __builtin_amdgcn_mfma_f32_16x16x32_bf16(Bt[n][k], At[m][k], acc[ai][bj][m][n], 0, 0, 0); __builtin_amdgcn_s_setprio(0); } while (0)
#define PG8_WAIT_V(n) asm volatile("s_waitcnt vmcnt(" #n ")" ::: "memory")
#define PG8_WAIT_L(n) asm volatile("s_waitcnt lgkmcnt(" #n ")" ::: "memory")
#define PG8_BAR __builtin_amdgcn_s_barrier()
#define PG8_SCHED __builtin_amdgcn_sched_barrier(0)
    Unit cur, nxt; int ui = 0;
    if (!S.next(0, cur)) return;
    f32x4 acc[2][2][4][2];
#pragma unroll
    for (int a = 0; a < 2; ++a)
#pragma unroll
        for (int b = 0; b < 2; ++b)
#pragma unroll
            for (int m = 0; m < 4; ++m)
#pragma unroll
                for (int n = 0; n < 2; ++n) acc[a][b][m][n] = (f32x4){0.f, 0.f, 0.f, 0.f};
    bf16x8 At[4][2], B0[2][2], B1[2][2];
    const char* cA = (const char*)g.A + (size_t)cur.pm * tstep; const char* cB = (const char*)g.Bt + (size_t)cur.pn * tstep;
    S.a_ready(cur);
    if constexpr (SP2) {
        PG8_STAGE(PG8_SB(0, 0), cB, voffB); PG8_STAGE(PG8_SB(0, 1), cB + hstep, voffB); PG8_STAGE(PG8_SA(0, 0), cA, voffA); PG8_STAGE(PG8_SA(0, 1), cA + hstep, voffA);
        if (wr == 1) PG8_BAR;
        PG8_WAIT_V(2); PG8_BAR;
        PG8_STAGE(PG8_SB(1, 0), cB + kstep, voffB); PG8_STAGE(PG8_SA(1, 0), cA + kstep, voffA); PG8_STAGE(PG8_SB(1, 1), cB + hstep + kstep, voffB);
        PG8_WAIT_V(6); PG8_BAR;
    } else {
        PG8_STAGE(PG8_SB(0, 0), cB, voffB); PG8_STAGE(PG8_SA(0, 0), cA, voffA); PG8_STAGE(PG8_SB(0, 1), cB + hstep, voffB); PG8_STAGE(PG8_SA(0, 1), cA + hstep, voffA);
        if (wr == 1) PG8_BAR;
        PG8_WAIT_V(4); PG8_BAR;
        PG8_STAGE(PG8_SB(1, 0), cB + kstep, voffB); PG8_STAGE(PG8_SA(1, 0), cA + kstep, voffA); PG8_STAGE(PG8_SB(1, 1), cB + hstep + kstep, voffB);
        PG8_WAIT_V(6); PG8_BAR;
    }
    for (;;) {
        const bool has_next = S.next(ui + 1, nxt);
        const char* nA = has_next ? (const char*)g.A + (size_t)nxt.pm * tstep : cA; const char* nB = has_next ? (const char*)g.Bt + (size_t)nxt.pn * tstep : cB;
        for (int t = 0; t < nt; t += 2) {
            const bool last = (t == nt - 2);
            const char* a1 = cA + (size_t)(t + 1) * kstep;
            const char* a2 = last ? nA : cA + (size_t)(t + 2) * kstep; const char* b2 = last ? nB : cB + (size_t)(t + 2) * kstep;
            const char* a3 = a2 + kstep; const char* b3 = b2 + kstep;
            if (last && has_next) S.a_ready(nxt);
            if constexpr (SP2) {
            PG8_LDB(B0, 0, 0); PG8_LDB(B1, 0, 1); PG8_SCHED; PG8_LDA(At, 0, 0); PG8_STAGE(PG8_SA(1, 1), a1 + hstep, voffA);
            PG8_WAIT_V(8); PG8_WAIT_L(0); PG8_BAR; PG8_MMA(0, 0, At, B0); PG8_MMA(0, 1, At, B1); PG8_BAR; PG8_SCHED;
            PG8_LDA(At, 0, 1); PG8_STAGE(PG8_SB(0, 0), b2, voffB); PG8_STAGE(PG8_SB(0, 1), b2 + hstep, voffB); PG8_STAGE(PG8_SA(0, 0), a2, voffA);
            PG8_WAIT_V(8); PG8_WAIT_L(0); PG8_BAR; PG8_MMA(1, 0, At, B0); PG8_MMA(1, 1, At, B1); PG8_BAR; PG8_SCHED;
            PG8_LDB(B0, 1, 0); PG8_LDB(B1, 1, 1); PG8_SCHED; PG8_LDA(At, 1, 0); PG8_STAGE(PG8_SA(0, 1), a2 + hstep, voffA);
            PG8_WAIT_V(8); PG8_WAIT_L(0); PG8_BAR; PG8_MMA(0, 0, At, B0); PG8_MMA(0, 1, At, B1); PG8_BAR; PG8_SCHED;
            PG8_LDA(At, 1, 1); PG8_STAGE(PG8_SB(1, 0), b3, voffB); PG8_STAGE(PG8_SB(1, 1), b3 + hstep, voffB); PG8_STAGE(PG8_SA(1, 0), a3, voffA);
            PG8_WAIT_V(8); PG8_WAIT_L(0); PG8_BAR; PG8_MMA(1, 0, At, B0); PG8_MMA(1, 1, At, B1); PG8_BAR; PG8_SCHED;
            } else {
            PG8_LDB(B0, 0, 0); PG8_SCHED; PG8_LDA(At, 0, 0); PG8_STAGE(PG8_SA(1, 1), a1 + hstep, voffA);
            PG8_WAIT_L(8); PG8_BAR; PG8_WAIT_L(0); PG8_MMA(0, 0, At, B0); PG8_BAR; PG8_SCHED;
            PG8_LDB(B1, 0, 1); PG8_STAGE(PG8_SB(0, 0), b2, voffB);
            PG8_BAR; PG8_WAIT_L(0); PG8_MMA(0, 1, At, B1); PG8_BAR;
            PG8_LDA(At, 0, 1); PG8_STAGE(PG8_SA(0, 0), a2, voffA);
            PG8_BAR; PG8_WAIT_L(0); PG8_MMA(1, 0, At, B0); PG8_BAR; PG8_SCHED;
            PG8_STAGE(PG8_SB(0, 1), b2 + hstep, voffB);
            PG8_WAIT_V(6); PG8_BAR; PG8_MMA(1, 1, At, B1); PG8_BAR;
            PG8_LDB(B0, 1, 0); PG8_SCHED; PG8_LDA(At, 1, 0); PG8_STAGE(PG8_SA(0, 1), a2 + hstep, voffA);
            PG8_WAIT_L(8); PG8_BAR; PG8_WAIT_L(0); PG8_MMA(0, 0, At, B0); PG8_BAR; PG8_SCHED;
            PG8_LDB(B1, 1, 1); PG8_STAGE(PG8_SB(1, 0), b3, voffB);
            PG8_BAR; PG8_WAIT_L(0); PG8_MMA(0, 1, At, B1); PG8_BAR;
            PG8_LDA(At, 1, 1); PG8_STAGE(PG8_SA(1, 0), a3, voffA);
            PG8_BAR; PG8_WAIT_L(0); PG8_MMA(1, 0, At, B0); PG8_BAR; PG8_SCHED;
            PG8_STAGE(PG8_SB(1, 1), b3 + hstep, voffB);
            PG8_WAIT_V(6); PG8_BAR; PG8_MMA(1, 1, At, B1); PG8_BAR;
            }
        }
        if constexpr (ALIGN_EPI) { if (wr == 0) PG8_BAR; }
        if constexpr (!Epi::AFTER_DRAIN) { E(acc, cur, wr, wc, fr, fq); S.done(cur); }
        if (!has_next) break;
#pragma unroll
        for (int a = 0; a < 2; ++a)
#pragma unroll
            for (int b = 0; b < 2; ++b)
#pragma unroll
                for (int m = 0; m < 4; ++m)
#pragma unroll
                    for (int n = 0; n < 2; ++n) acc[a][b][m][n] = (f32x4){0.f, 0.f, 0.f, 0.f};
        cur = nxt; cA = nA; cB = nB; ++ui;
        if constexpr (ALIGN_EPI) { if (wr == 1) PG8_BAR; }
    }
    PG8_WAIT_V(0);
    if constexpr (!ALIGN_EPI) { if (wr == 0) PG8_BAR; }
    PG8_BAR;
    if constexpr (Epi::AFTER_DRAIN) { E.fused(acc, cur, wr, wc, fr, fq, lds, wid, lane); S.done(cur); }
#undef PG8_SA
#undef PG8_SB
#undef PG8_STAGE
#undef PG8_LDA
#undef PG8_LDB
#undef PG8_MMA
#undef PG8_WAIT_V
#undef PG8_WAIT_L
#undef PG8_BAR
#undef PG8_SCHED
}
}
constexpr int SEQ = 2048, BATCH = 8, M = BATCH * SEQ, D = 1024, DFF = 4096, DIN = 2048, NCV = 3072, NH = 32, NIN = 5152, MODW = 6144;
constexpr float EPS = 1e-5f;
constexpr size_t MiB = 1u << 20;
constexpr size_t WS_MODP = 1 * MiB;
constexpr size_t WS_MOD = 2 * MiB + 512 * 1024;
constexpr size_t WS_WIN = 3 * MiB, WS_WOUT = 14 * MiB, WS_WUP0 = 18 * MiB, WS_WUP1 = 26 * MiB, WS_WDN0 = 34 * MiB, WS_WDN1 = 42 * MiB, WS_WSCIN = 50 * MiB, WS_WSCOUT = 56 * MiB;
constexpr size_t WS_DT = 58 * MiB, WS_SS = 60 * MiB, WS_H = 62 * MiB, WS_Z = 94 * MiB, WS_XBC = 158 * MiB, WS_END = 254 * MiB;
constexpr size_t WS_ACT = WS_Z, WS_PROJ = WS_Z, WS_YSC = WS_Z + 96 * MiB;
constexpr int LDS_BYTES = 147456;

#define LAS __attribute__((address_space(3)))
typedef unsigned short bf16;
typedef unsigned u32x4 __attribute__((ext_vector_type(4)));
typedef unsigned u32x2 __attribute__((ext_vector_type(2)));
typedef float f32x4 __attribute__((ext_vector_type(4)));
typedef short bf16x8 __attribute__((ext_vector_type(8)));

__device__ __forceinline__ unsigned pk2(float lo, float hi) { unsigned r; asm("v_cvt_pk_bf16_f32 %0, %1, %2" : "=v"(r) : "v"(lo), "v"(hi)); return r; }
__device__ __forceinline__ float bflo(unsigned w) { return __uint_as_float(w << 16); }
__device__ __forceinline__ float bfhi(unsigned w) { return __uint_as_float(w & 0xffff0000u); }
__device__ __forceinline__ float bf1(bf16 v) { return __uint_as_float(((unsigned)v) << 16); }
__device__ __forceinline__ float fexp(float x) { return __builtin_amdgcn_exp2f(x * 1.4426950408889634f); }
__device__ __forceinline__ float silu_f(float v) { return v * __builtin_amdgcn_rcpf(1.0f + fexp(-v)); }
__device__ __forceinline__ float wave_sum(float v) {
#pragma unroll
    for (int o = 1; o < 64; o <<= 1) v += __shfl_xor(v, o);
    return v;
}
#define LDS_WAIT() asm volatile("s_waitcnt lgkmcnt(0)" ::: "memory")

struct Args { const float* in[20]; float* out; unsigned char* ws; };
enum { I_X = 0, I_C, I_ADAW, I_ADAB, I_MIXNW, I_MLPNW, I_UP, I_DOWN, I_SSDIN, I_SSDCW, I_SSDCB, I_DTB, I_ALOG, I_DSK, I_SSDNW, I_SSDOUT, I_SCIN, I_SCCW, I_SCOUT, I_FNW };

__device__ __forceinline__ void transpose_item(const float* W, int K, int N, bf16* WT, LAS float* scr, int item, int lane) {
    const int nblk = N / 32, kb = item / nblk, nb = item % nblk, k0 = 64 * kb, n0 = 32 * nb;
#pragma unroll 8
    for (int i = 0; i < 32; ++i) { const int kk = 2 * i + (lane >> 5); scr[kk * 33 + (lane & 31)] = W[(size_t)(k0 + kk) * N + n0 + (lane & 31)]; }
    LDS_WAIT(); asm volatile("" ::: "memory");
    const int c = lane & 7;
#pragma unroll
    for (int j = 0; j < 4; ++j) { const int n = (lane >> 3) + 8 * j; const LAS float* s = scr + (8 * c) * 33 + n;
        u32x4 o; o.x = pk2(s[0 * 33], s[1 * 33]); o.y = pk2(s[2 * 33], s[3 * 33]); o.z = pk2(s[4 * 33], s[5 * 33]); o.w = pk2(s[6 * 33], s[7 * 33]);
        *(u32x4*)(WT + (size_t)(n0 + n) * K + k0 + 8 * c) = o; }
    LDS_WAIT(); asm volatile("" ::: "memory");
}

__device__ __forceinline__ void p0_phase(const Args& a, LAS unsigned char* lds, int bid, int G, int tid, int lane, int wave) {
    unsigned char* ws = a.ws;
    LAS float* cond = (LAS float*)lds;
    LAS float* red = (LAS float*)(lds + 32768);
    const float* cin = a.in[I_C];
    for (int i = tid; i < 8192; i += 512) cond[i] = silu_f(cin[i]);
    __syncthreads();
    float* modp = (float*)(ws + WS_MODP);
    for (int it = bid; it < 768; it += G) {
        const int i = it / 384, r = it % 384, cb = r >> 2, ks = r & 3, n0 = cb * 64, k0 = ks * 256 + wave * 32;
        const float* wp = a.in[I_ADAW] + ((size_t)i * 1024 + k0) * MODW + n0 + lane;
        float acc[8];
#pragma unroll
        for (int b = 0; b < 8; ++b) acc[b] = 0.f;
#pragma unroll 8
        for (int kk = 0; kk < 32; ++kk) { const float wv = wp[(size_t)kk * MODW];
#pragma unroll
            for (int b = 0; b < 8; ++b) acc[b] += cond[b * 1024 + k0 + kk] * wv; }
#pragma unroll
        for (int b = 0; b < 8; ++b) red[(wave * 8 + b) * 64 + lane] = acc[b];
        __syncthreads();
        { const int b = tid >> 6; float s = 0.f;
#pragma unroll
          for (int w = 0; w < 8; ++w) s += red[(w * 8 + b) * 64 + lane];
          modp[(size_t)((ks * 2 + i) * 8 + b) * MODW + n0 + lane] = s; }
        __syncthreads();
    }
    LAS float* scr = (LAS float*)(lds + wave * 16384);
    const int gw = bid * 8 + wave, NGW = G * 8;
    constexpr int I0 = 16 * 161, I1 = 32 * 32, I2 = 16 * 128, I4 = 64 * 32, I6 = 16 * 96, I7 = 16 * 32;
    constexpr int NITEMS = I0 + I1 + 2 * I2 + 2 * I4 + I6 + I7;
    for (int it = gw; it < NITEMS; it += NGW) {
        int r = it;
        if (r < I0) { transpose_item(a.in[I_SSDIN], D, NIN, (bf16*)(ws + WS_WIN), scr, r, lane); continue; } r -= I0;
        if (r < I1) { transpose_item(a.in[I_SSDOUT], DIN, D, (bf16*)(ws + WS_WOUT), scr, r, lane); continue; } r -= I1;
        if (r < I2) { transpose_item(a.in[I_UP], D, DFF, (bf16*)(ws + WS_WUP0), scr, r, lane); continue; } r -= I2;
        if (r < I2) { transpose_item(a.in[I_UP] + (size_t)D * DFF, D, DFF, (bf16*)(ws + WS_WUP1), scr, r, lane); continue; } r -= I2;
        if (r < I4) { transpose_item(a.in[I_DOWN], DFF, D, (bf16*)(ws + WS_WDN0), scr, r, lane); continue; } r -= I4;
        if (r < I4) { transpose_item(a.in[I_DOWN] + (size_t)D * DFF, DFF, D, (bf16*)(ws + WS_WDN1), scr, r, lane); continue; } r -= I4;
        if (r < I6) { transpose_item(a.in[I_SCIN], D, 3 * D, (bf16*)(ws + WS_WSCIN), scr, r, lane); continue; } r -= I6;
        transpose_item(a.in[I_SCOUT], D, D, (bf16*)(ws + WS_WSCOUT), scr, r, lane);
    }
}

template <bool PART>
__device__ __forceinline__ void norm_phase(const Args& a, LAS unsigned char* lds, const float* src, const float* gw, int layer, int off_sh, int off_sc, bf16* dst,
                                           int bid, int G, int tid, int lane, int wave) {
    LAS float* Aw = (LAS float*)lds; LAS float* Sw = (LAS float*)(lds + 4096);
    const float* modp = (const float*)(a.ws + WS_MODP); const float* mod = (const float*)(a.ws + WS_MOD);
    for (int ck = bid; ck < 256; ck += G) {
        const int row0 = ck * 64, b = row0 >> 11;
        __syncthreads();
        for (int k = tid; k < 1024; k += 512) {
            float sc, sh;
            if (PART) { sc = a.in[I_ADAB][layer * MODW + off_sc + k]; sh = a.in[I_ADAB][layer * MODW + off_sh + k];
#pragma unroll
                for (int ks = 0; ks < 4; ++ks) { const float* p = modp + (size_t)((ks * 2 + layer) * 8 + b) * MODW; sc += p[off_sc + k]; sh += p[off_sh + k]; } }
            else { const float* p = mod + (size_t)(layer * 8 + b) * MODW; sc = p[off_sc + k]; sh = p[off_sh + k]; }
            Aw[k] = gw[k] * (1.0f + sc); Sw[k] = sh; }
        __syncthreads();
        for (int rr = wave; rr < 64; rr += 8) {
            const int row = row0 + rr;
            const f32x4* xr = (const f32x4*)(src + (size_t)row * D) + lane;
            f32x4 v[4]; float s = 0.f;
#pragma unroll
            for (int j = 0; j < 4; ++j) { v[j] = xr[64 * j]; s += (v[j].x * v[j].x + v[j].y * v[j].y) + (v[j].z * v[j].z + v[j].w * v[j].w); }
            const float rstd = __builtin_amdgcn_rsqf(wave_sum(s) * (1.f / D) + EPS);
            u32x2* o8 = (u32x2*)(dst + (size_t)row * D) + lane;
#pragma unroll
            for (int j = 0; j < 4; ++j) { const f32x4 aw = *(const LAS f32x4*)(Aw + 4 * lane + 256 * j), sw = *(const LAS f32x4*)(Sw + 4 * lane + 256 * j);
                const f32x4 o = v[j] * rstd * aw + sw; u32x2 w; w.x = pk2(o.x, o.y); w.y = pk2(o.z, o.w); o8[64 * j] = w; }
        }
    }
}
__device__ __forceinline__ void mod_finalize(const Args& a, int bid, int G, int tid) {
    const float* modp = (const float*)(a.ws + WS_MODP); float* mod = (float*)(a.ws + WS_MOD);
    for (int idx = bid * 512 + tid; idx < 2 * 8 * MODW; idx += G * 512) {
        const int i = idx / (8 * MODW), rem = idx % (8 * MODW), j = rem % MODW;
        float v = a.in[I_ADAB][i * MODW + j];
#pragma unroll
        for (int ks = 0; ks < 4; ++ks) v += modp[(size_t)(ks * 2 + i) * (8 * MODW) + rem];
        mod[idx] = v; }
}

__device__ __forceinline__ void dt_phase(const Args& a, int bid, int G, int lane, int wave) {
    const bf16* H = (const bf16*)(a.ws + WS_H); const bf16* WT = (const bf16*)(a.ws + WS_WIN); float* DT = (float*)(a.ws + WS_DT);
    const int fr = lane & 15, fq = lane >> 4;
    const f32x4 bias0 = *(const f32x4*)(a.in[I_DTB] + 4 * fq), bias1 = *(const f32x4*)(a.in[I_DTB] + 16 + 4 * fq);
    for (int it = bid * 8 + wave; it < M / 16; it += G * 8) {
        const int m0 = it * 16;
        const bf16* ap = H + (size_t)(m0 + fr) * D + 8 * fq;
        const bf16* bp0 = WT + (size_t)(5120 + fr) * D + 8 * fq; const bf16* bp1 = bp0 + (size_t)16 * D;
        f32x4 acc0 = {0.f, 0.f, 0.f, 0.f}, acc1 = {0.f, 0.f, 0.f, 0.f};
#pragma unroll 4
        for (int k0 = 0; k0 < D; k0 += 32) {
            const bf16x8 av = *(const bf16x8*)(ap + k0), b0 = *(const bf16x8*)(bp0 + k0), b1 = *(const bf16x8*)(bp1 + k0);
            acc0 = __builtin_amdgcn_mfma_f32_16x16x32_bf16(b0, av, acc0, 0, 0, 0);
            acc1 = __builtin_amdgcn_mfma_f32_16x16x32_bf16(b1, av, acc1, 0, 0, 0); }
        f32x4 o0, o1;
#pragma unroll
        for (int j = 0; j < 4; ++j) { const float x0 = acc0[j] + bias0[j], x1 = acc1[j] + bias1[j];
            o0[j] = fmaxf(x0, 0.f) + log1pf(expf(-fabsf(x0))); o1[j] = fmaxf(x1, 0.f) + log1pf(expf(-fabsf(x1))); }
        *(f32x4*)(DT + (size_t)(m0 + fr) * NH + 4 * fq) = o0; *(f32x4*)(DT + (size_t)(m0 + fr) * NH + 16 + 4 * fq) = o1;
    }
}
constexpr int RSB = 272;
constexpr int S_BM = 0, S_CM = 34816, S_BDT = 69632, S_XDT = 104448, S_ST = 121856, S_ACS = 139264, S_DTV = 139776, S_CW = 140288;
static_assert(S_CW + 5 * 320 * 4 <= LDS_BYTES, "SSD LDS map");
__device__ __forceinline__ float wave_scan_incl(float v, int lane) {
#pragma unroll
    for (int o = 1; o < 64; o <<= 1) { const float t = __shfl_up(v, o); if (lane >= o) v += t; }
    return v;
}
template <int NR>
__device__ __forceinline__ void conv_col(const u32x4 (&raw)[NR + 3], int j, const LAS float* cw, float (&o)[NR]) {
    float rf[NR + 3];
#pragma unroll
    for (int i = 0; i < NR + 3; ++i) { const unsigned w = raw[i][j >> 1]; rf[i] = (j & 1) ? bfhi(w) : bflo(w); }
    const float w0 = cw[j], w1 = cw[320 + j], w2 = cw[640 + j], w3 = cw[960 + j], bb = cw[1280 + j];
#pragma unroll
    for (int i = 0; i < NR; ++i) o[i] = silu_f(bb + w0 * rf[i] + w1 * rf[i + 1] + w2 * rf[i + 2] + w3 * rf[i + 3]);
}
__device__ __forceinline__ void ssd_phase(const Args& a, LAS unsigned char* lds, int bid, int G, int tid, int lane, int wave) {
    const bf16* XBC = (const bf16*)(a.ws + WS_XBC); bf16* Z = (bf16*)(a.ws + WS_Z); const float* DT = (const float*)(a.ws + WS_DT); float* SS = (float*)(a.ws + WS_SS);
    const int fr = lane & 15, fq = lane >> 4;
    LAS float* Acs = (LAS float*)(lds + S_ACS); LAS float* dtv = (LAS float*)(lds + S_DTV); LAS float* CW = (LAS float*)(lds + S_CW);
    for (int item = bid; item < 256; item += G) {
        const int xcd = item & 7, jj = item >> 3, pg = xcd * 4 + (jj >> 3), hh = jj & 7, b = pg >> 2, g = pg & 3, h = g * 8 + hh;
        const float A_h = -expf(a.in[I_ALOG][h]), D_h = a.in[I_DSK][h];
        __syncthreads();
        for (int i = tid; i < 5 * 320; i += 512) { const int k = i / 320, cl = i % 320;
            const int ch = cl < 64 ? h * 64 + cl : (cl < 192 ? 2048 + g * 128 + (cl - 64) : 2560 + g * 128 + (cl - 192));
            CW[i] = (k < 4) ? a.in[I_SSDCW][k * NCV + ch] : a.in[I_SSDCB][ch]; }
        for (int i = tid; i < 17408 / 4; i += 512) ((LAS unsigned*)(lds + S_ST))[i] = 0u;
        f32x4 sacc[4];
#pragma unroll
        for (int pb = 0; pb < 4; ++pb) sacc[pb] = (f32x4){0.f, 0.f, 0.f, 0.f};
        __syncthreads();
        for (int c = 0; c < 16; ++c) {
            const int t0 = b * SEQ + c * 128;
            if (wave < 2) {
                const float d0 = DT[(size_t)(t0 + lane) * NH + h];
                const float s0 = wave_scan_incl(d0 * A_h, lane);
                if (wave == 0) { Acs[lane] = s0; dtv[lane] = d0; }
                else { const float tot0 = __shfl(s0, 63); const float d1 = DT[(size_t)(t0 + 64 + lane) * NH + h];
                       const float s1 = wave_scan_incl(d1 * A_h, lane); Acs[64 + lane] = s1 + tot0; dtv[64 + lane] = d1; }
            }
            {
                const int cgp = tid & 15, rs = tid >> 4;
                const bf16* src = XBC + (ptrdiff_t)(t0 + 4 * rs - 3) * NCV + 2560 + g * 128 + 8 * cgp;
                u32x4 raw[7];
#pragma unroll
                for (int i = 0; i < 7; ++i) { const bool ok = (c > 0) || (4 * rs - 3 + i >= 0); raw[i] = ok ? *(const u32x4*)(src + (ptrdiff_t)i * NCV) : (u32x4){0u, 0u, 0u, 0u}; }
                unsigned pk[4][4];
#pragma unroll
                for (int j2 = 0; j2 < 4; ++j2) { float oa[4], ob[4]; conv_col<4>(raw, 2 * j2, CW + 192 + 8 * cgp, oa); conv_col<4>(raw, 2 * j2 + 1, CW + 192 + 8 * cgp, ob);
#pragma unroll
                    for (int i = 0; i < 4; ++i) pk[i][j2] = pk2(oa[i], ob[i]); }
#pragma unroll
                for (int i = 0; i < 4; ++i) *(LAS u32x4*)(lds + S_CM + (4 * rs + i) * RSB + cgp * 16) = (u32x4){pk[i][0], pk[i][1], pk[i][2], pk[i][3]};
            }
            __syncthreads();
            {
                const int cgp = tid & 15, rs = tid >> 4;
                const bf16* src = XBC + (ptrdiff_t)(t0 + 4 * rs - 3) * NCV + 2048 + g * 128 + 8 * cgp;
                u32x4 raw[7];
#pragma unroll
                for (int i = 0; i < 7; ++i) { const bool ok = (c > 0) || (4 * rs - 3 + i >= 0); raw[i] = ok ? *(const u32x4*)(src + (ptrdiff_t)i * NCV) : (u32x4){0u, 0u, 0u, 0u}; }
                const float alast = Acs[127]; const f32x4 as4 = *(const LAS f32x4*)(Acs + 4 * rs);
                float E[4];
#pragma unroll
                for (int i = 0; i < 4; ++i) E[i] = fexp(alast - as4[i]);
                unsigned pk[4][4];
#pragma unroll
                for (int j2 = 0; j2 < 4; ++j2) { float oa[4], ob[4]; conv_col<4>(raw, 2 * j2, CW + 64 + 8 * cgp, oa); conv_col<4>(raw, 2 * j2 + 1, CW + 64 + 8 * cgp, ob);
#pragma unroll
                    for (int i = 0; i < 4; ++i) pk[i][j2] = pk2(oa[i], ob[i]);
                    *(LAS u32x2*)(lds + S_BDT + (8 * cgp + 2 * j2) * RSB + rs * 8) = (u32x2){pk2(oa[0] * E[0], oa[1] * E[1]), pk2(oa[2] * E[2], oa[3] * E[3])};
                    *(LAS u32x2*)(lds + S_BDT + (8 * cgp + 2 * j2 + 1) * RSB + rs * 8) = (u32x2){pk2(ob[0] * E[0], ob[1] * E[1]), pk2(ob[2] * E[2], ob[3] * E[3])}; }
#pragma unroll
                for (int i = 0; i < 4; ++i) *(LAS u32x4*)(lds + S_BM + (4 * rs + i) * RSB + cgp * 16) = (u32x4){pk[i][0], pk[i][1], pk[i][2], pk[i][3]};
            }
            {
                const int cgp = tid & 7, rs = tid >> 3;
                const bf16* src = XBC + (ptrdiff_t)(t0 + 2 * rs - 3) * NCV + h * 64 + 8 * cgp;
                u32x4 raw[5];
#pragma unroll
                for (int i = 0; i < 5; ++i) { const bool ok = (c > 0) || (2 * rs - 3 + i >= 0); raw[i] = ok ? *(const u32x4*)(src + (ptrdiff_t)i * NCV) : (u32x4){0u, 0u, 0u, 0u}; }
                const float d0 = dtv[2 * rs], d1 = dtv[2 * rs + 1];
#pragma unroll
                for (int j = 0; j < 8; ++j) { float o[2]; conv_col<2>(raw, j, CW + 8 * cgp, o);
                    *(LAS unsigned*)(lds + S_XDT + (8 * cgp + j) * RSB + rs * 4) = pk2(o[0] * d0, o[1] * d1); }
            }
            __syncthreads();
            bf16x8 Cf[4];
#pragma unroll
            for (int kk = 0; kk < 4; ++kk) Cf[kk] = *(const LAS bf16x8*)(lds + S_CM + (16 * wave + fr) * RSB + (32 * kk + 8 * fq) * 2);
            unsigned Mw[4][4];
#pragma unroll
            for (int kb = 0; kb < 4; ++kb)
#pragma unroll
                for (int e = 0; e < 4; ++e) Mw[kb][e] = 0u;
            const float acs_l = Acs[16 * wave + fr]; const int lidx = 16 * wave + fr;
#pragma unroll
            for (int sb = 0; sb < 8; ++sb) {
                if (sb <= wave) {
                    f32x4 s = {0.f, 0.f, 0.f, 0.f};
#pragma unroll
                    for (int kk = 0; kk < 4; ++kk) { const bf16x8 af = *(const LAS bf16x8*)(lds + S_BM + (16 * sb + fr) * RSB + (32 * kk + 8 * fq) * 2);
                        s = __builtin_amdgcn_mfma_f32_16x16x32_bf16(af, Cf[kk], s, 0, 0, 0); }
                    const f32x4 as4 = *(const LAS f32x4*)(Acs + 16 * sb + 4 * fq);
                    float v[4];
#pragma unroll
                    for (int i = 0; i < 4; ++i) { const int sidx = 16 * sb + 4 * fq + i; const float e = fexp(fminf(acs_l - as4[i], 0.f)); v[i] = (sidx <= lidx) ? s[i] * e : 0.f; }
                    Mw[sb >> 1][(sb & 1) * 2 + 0] = pk2(v[0], v[1]); Mw[sb >> 1][(sb & 1) * 2 + 1] = pk2(v[2], v[3]);
                }
            }
            f32x4 yd[4], yo[4];
#pragma unroll
            for (int pb = 0; pb < 4; ++pb) { yd[pb] = (f32x4){0.f, 0.f, 0.f, 0.f}; yo[pb] = (f32x4){0.f, 0.f, 0.f, 0.f}; }
#pragma unroll
            for (int kb = 0; kb < 4; ++kb) {
                if (2 * kb <= wave) {
                    const u32x4 mw = {Mw[kb][0], Mw[kb][1], Mw[kb][2], Mw[kb][3]}; const bf16x8 mf = __builtin_bit_cast(bf16x8, mw);
#pragma unroll
                    for (int pb = 0; pb < 4; ++pb) { const u32x2 lo = *(const LAS u32x2*)(lds + S_XDT + (16 * pb + fr) * RSB + (32 * kb + 4 * fq) * 2);
                        const u32x2 hi = *(const LAS u32x2*)(lds + S_XDT + (16 * pb + fr) * RSB + (32 * kb + 16 + 4 * fq) * 2);
                        const u32x4 xw = {lo.x, lo.y, hi.x, hi.y};
                        yd[pb] = __builtin_amdgcn_mfma_f32_16x16x32_bf16(mf, __builtin_bit_cast(bf16x8, xw), yd[pb], 0, 0, 0); }
                }
            }
            if (c > 0) {
#pragma unroll
                for (int kk = 0; kk < 4; ++kk)
#pragma unroll
                    for (int pb = 0; pb < 4; ++pb) { const bf16x8 sf = *(const LAS bf16x8*)(lds + S_ST + (16 * pb + fr) * RSB + (32 * kk + 8 * fq) * 2);
                        yo[pb] = __builtin_amdgcn_mfma_f32_16x16x32_bf16(Cf[kk], sf, yo[pb], 0, 0, 0); }
            }
            {
                const f32x4 al4 = *(const LAS f32x4*)(Acs + 16 * wave + 4 * fq), dt4 = *(const LAS f32x4*)(dtv + 16 * wave + 4 * fq);
                float ea[4], rdt[4], ssq[4];
#pragma unroll
                for (int i = 0; i < 4; ++i) { ea[i] = fexp(al4[i]); rdt[i] = 1.0f / dt4[i]; ssq[i] = 0.f; }
#pragma unroll
                for (int pb = 0; pb < 4; ++pb) {
                    const u32x2 xd = *(const LAS u32x2*)(lds + S_XDT + (16 * pb + fr) * RSB + (16 * wave + 4 * fq) * 2);
                    const float xv[4] = {bflo(xd.x), bfhi(xd.x), bflo(xd.y), bfhi(xd.y)};
#pragma unroll
                    for (int i = 0; i < 4; ++i) {
                        bf16* zp = Z + (size_t)(t0 + 16 * wave + 4 * fq + i) * DIN + h * 64 + 16 * pb + fr;
                        const float z = bf1(*zp);
                        const float y = yd[pb][i] + ea[i] * yo[pb][i] + D_h * xv[i] * rdt[i];
                        const float yz = y * silu_f(z);
                        *zp = (bf16)(pk2(yz, 0.f) & 0xffffu); ssq[i] += yz * yz;
                    }
                }
#pragma unroll
                for (int i = 0; i < 4; ++i) { float s = ssq[i]; s += __shfl_xor(s, 1); s += __shfl_xor(s, 2); s += __shfl_xor(s, 4); s += __shfl_xor(s, 8);
                    if (fr == 0) SS[(size_t)(t0 + 16 * wave + 4 * fq + i) * NH + h] = s; }
            }
            if (c < 15) {
                const float dec = fexp(Acs[127]);
#pragma unroll
                for (int pb = 0; pb < 4; ++pb) sacc[pb] = sacc[pb] * dec;
#pragma unroll
                for (int ks = 0; ks < 4; ++ks) { const bf16x8 bfr = *(const LAS bf16x8*)(lds + S_BDT + (16 * wave + fr) * RSB + (32 * ks + 8 * fq) * 2);
#pragma unroll
                    for (int pb = 0; pb < 4; ++pb) { const bf16x8 xf = *(const LAS bf16x8*)(lds + S_XDT + (16 * pb + fr) * RSB + (32 * ks + 8 * fq) * 2);
                        sacc[pb] = __builtin_amdgcn_mfma_f32_16x16x32_bf16(bfr, xf, sacc[pb], 0, 0, 0); } }
            }
            __syncthreads();
            if (c < 15) {
#pragma unroll
                for (int pb = 0; pb < 4; ++pb) *(LAS u32x2*)(lds + S_ST + (16 * pb + fr) * RSB + (16 * wave + 4 * fq) * 2) = (u32x2){pk2(sacc[pb][0], sacc[pb][1]), pk2(sacc[pb][2], sacc[pb][3])};
            }
        }
    }
}

__device__ __forceinline__ void gnorm_phase(const Args& a, int bid, int G, int lane, int wave) {
    bf16* YZ = (bf16*)(a.ws + WS_Z); const float* SS = (const float*)(a.ws + WS_SS); const float* nw = a.in[I_SSDNW];
    for (int row = bid * 8 + wave; row < M; row += G * 8) {
#pragma unroll
        for (int g = 0; g < 4; ++g) {
            u32x4* p = (u32x4*)(YZ + (size_t)row * DIN + g * 512 + lane * 8);
            const u32x4 v = *p;
            float s = SS[(size_t)row * NH + g * 8 + (lane & 7)]; s += __shfl_xor(s, 1); s += __shfl_xor(s, 2); s += __shfl_xor(s, 4);
            const float rs = __builtin_amdgcn_rsqf(s * (1.0f / 512.0f) + EPS);
            const f32x4 w0 = *(const f32x4*)(nw + g * 512 + lane * 8), w1 = *(const f32x4*)(nw + g * 512 + lane * 8 + 4);
            u32x4 o; o.x = pk2(bflo(v.x) * rs * w0.x, bfhi(v.x) * rs * w0.y); o.y = pk2(bflo(v.y) * rs * w0.z, bfhi(v.y) * rs * w0.w);
            o.z = pk2(bflo(v.z) * rs * w1.x, bfhi(v.z) * rs * w1.y); o.w = pk2(bflo(v.w) * rs * w1.z, bfhi(v.w) * rs * w1.w);
            *p = o;
        }
    }
}

__device__ __forceinline__ void sconv_phase(const Args& a, int bid, int G, int lane, int wave) {
    const bf16* P = (const bf16*)(a.ws + WS_PROJ); bf16* Y = (bf16*)(a.ws + WS_YSC); const float* cw = a.in[I_SCCW];
    for (int it = bid * 8 + wave; it < 2048; it += G * 8) {
        const int seg = it >> 1, col = (it & 1) * 512 + lane * 8, row0 = seg * 16;
        float w[3][8];
#pragma unroll
        for (int k = 0; k < 3; ++k) { const f32x4 a0 = *(const f32x4*)(cw + k * D + col), a1 = *(const f32x4*)(cw + k * D + col + 4);
            w[k][0] = a0.x; w[k][1] = a0.y; w[k][2] = a0.z; w[k][3] = a0.w; w[k][4] = a1.x; w[k][5] = a1.y; w[k][6] = a1.z; w[k][7] = a1.w; }
        float u2[8], u1[8];
#pragma unroll
        for (int j = 0; j < 8; ++j) { u2[j] = 0.f; u1[j] = 0.f; }
        if ((row0 & (SEQ - 1)) != 0) {
            const u32x4 c2 = *(const u32x4*)(P + (size_t)(row0 - 2) * NCV + D + col), x2 = *(const u32x4*)(P + (size_t)(row0 - 2) * NCV + 2 * D + col);
            const u32x4 c1 = *(const u32x4*)(P + (size_t)(row0 - 1) * NCV + D + col), x1 = *(const u32x4*)(P + (size_t)(row0 - 1) * NCV + 2 * D + col);
#pragma unroll
            for (int q = 0; q < 4; ++q) { u2[2 * q] = bflo(c2[q]) * bflo(x2[q]); u2[2 * q + 1] = bfhi(c2[q]) * bfhi(x2[q]); u1[2 * q] = bflo(c1[q]) * bflo(x1[q]); u1[2 * q + 1] = bfhi(c1[q]) * bfhi(x1[q]); }
        }
#pragma unroll 4
        for (int r = 0; r < 16; ++r) {
            const bf16* rp = P + (size_t)(row0 + r) * NCV + col;
            const u32x4 bg = *(const u32x4*)rp, cv = *(const u32x4*)(rp + D), xv = *(const u32x4*)(rp + 2 * D);
            float u0[8], y[8];
#pragma unroll
            for (int q = 0; q < 4; ++q) { u0[2 * q] = bflo(cv[q]) * bflo(xv[q]); u0[2 * q + 1] = bfhi(cv[q]) * bfhi(xv[q]); }
#pragma unroll
            for (int j = 0; j < 8; ++j) { const float bgv = (j & 1) ? bfhi(bg[j >> 1]) : bflo(bg[j >> 1]); y[j] = bgv * (w[0][j] * u2[j] + w[1][j] * u1[j] + w[2][j] * u0[j]); u2[j] = u1[j]; u1[j] = u0[j]; }
            *(u32x4*)(Y + (size_t)(row0 + r) * D + col) = (u32x4){pk2(y[0], y[1]), pk2(y[2], y[3]), pk2(y[4], y[5]), pk2(y[6], y[7])};
        }
    }
}

__device__ __forceinline__ void fnorm_phase(const Args& a, int bid, int G, int lane, int wave) {
    const float* gw = a.in[I_FNW];
    for (int row = bid * 8 + wave; row < M; row += G * 8) {
        f32x4* xr = (f32x4*)(a.out + (size_t)row * D) + lane;
        f32x4 v[4]; float s = 0.f;
#pragma unroll
        for (int j = 0; j < 4; ++j) { v[j] = xr[64 * j]; s += (v[j].x * v[j].x + v[j].y * v[j].y) + (v[j].z * v[j].z + v[j].w * v[j].w); }
        const float rstd = __builtin_amdgcn_rsqf(wave_sum(s) * (1.f / D) + EPS);
#pragma unroll
        for (int j = 0; j < 4; ++j) { const f32x4 w = *(const f32x4*)(gw + 4 * lane + 256 * j); xr[64 * j] = v[j] * rstd * w; }
    }
}


#define XB_TMO      128
#define XB_XCNT(j)  (256  + 64 * (j))
#define XB_XSUB(j)  (1280 + 64 * (j))
#define XB_XGEN(j)  (2304 + 64 * (j))
#define XB_TOP      3328
#define XB_TOPGEN   3392
#define XCD_BAR_WORDS 3456
#define XB_SPIN_CAP (1u << 18)

__device__ __forceinline__ unsigned xb_ld(unsigned* p)              { return __hip_atomic_load(p, __ATOMIC_RELAXED, __HIP_MEMORY_SCOPE_AGENT); }
__device__ __forceinline__ unsigned xb_add(unsigned* p, unsigned v) { return __hip_atomic_fetch_add(p, v, __ATOMIC_RELAXED, __HIP_MEMORY_SCOPE_AGENT); }
__device__ __forceinline__ unsigned xb_xcc_id() { return (unsigned)__builtin_amdgcn_s_getreg((3 << 11) | 20) & 0xFu; }
#define XB_SPIN(cond, bar) do { unsigned _sp = 0; while (cond) { __builtin_amdgcn_s_sleep(1); \
    if ((++_sp & 255u) == 0u) { if (xb_ld(&(bar)[XB_TMO])) break; if (_sp > XB_SPIN_CAP) { atomicAdd(&(bar)[XB_TMO], 1u); break; } } } } while (0)

struct XcdBarrier {
    unsigned* bar; unsigned x;
    volatile LAS unsigned* st;
};

__device__ __forceinline__ XcdBarrier xcd_barrier_post(unsigned* bar, volatile LAS unsigned* st) {
    XcdBarrier b; b.bar = bar; b.x = xb_xcc_id(); b.st = st;
    if (threadIdx.x == 0) (void)xb_add(&bar[XB_XCNT(b.x)], 1u);
    return b;
}
__device__ __forceinline__ void xcd_barrier_complete(unsigned* bar, unsigned x, unsigned& nloc, unsigned& nx) {
    const unsigned G = gridDim.x * gridDim.y * gridDim.z;
    unsigned sum, cnt, mine, sp = 0u;
    for (;;) {
        sum = 0u; cnt = 0u; mine = 0u;
#pragma unroll
        for (unsigned j = 0; j < 16; ++j) { const unsigned c = xb_ld(&bar[XB_XCNT(j)]); sum += c; cnt += (c > 0u) ? 1u : 0u; mine = (j == x) ? c : mine; }
        if (sum == G) break;
        __builtin_amdgcn_s_sleep(1);
        if ((++sp & 255u) == 0u) { if (xb_ld(&bar[XB_TMO])) break; if (sp > XB_SPIN_CAP) { atomicAdd(&bar[XB_TMO], 1u); break; } }
    }
    nloc = mine > 0u ? mine : 1u; nx = cnt > 0u ? cnt : 1u;
}

__device__ __forceinline__ void xcd_barrier(const XcdBarrier& b) {
    asm volatile("s_waitcnt vmcnt(0)" ::: "memory");
    __syncthreads();
    if (threadIdx.x == 0) {
        unsigned* bar = b.bar;
        __builtin_amdgcn_s_waitcnt(0);
        unsigned nloc = b.st[0], nx = b.st[1];
        if (nloc == 0u) { xcd_barrier_complete(bar, b.x, nloc, nx); b.st[0] = nloc; b.st[1] = nx; }
        const unsigned old = xb_add(&bar[XB_XSUB(b.x)], 1u);
        const unsigned gen = old / nloc;
        if (old + 1u == (gen + 1u) * nloc) {
            __builtin_amdgcn_fence(__ATOMIC_RELEASE, "agent");
            asm volatile("s_waitcnt vmcnt(0)" ::: "memory");
            const unsigned og = xb_add(&bar[XB_TOP], 1u);
            const unsigned tg = og / nx;
            if (og + 1u == (tg + 1u) * nx) xb_add(&bar[XB_TOPGEN], 1u);
            else XB_SPIN(xb_ld(&bar[XB_TOPGEN]) == tg, bar);
            __builtin_amdgcn_fence(__ATOMIC_ACQUIRE, "agent");
            xb_add(&bar[XB_XGEN(b.x)], 1u);
            asm volatile("s_waitcnt vmcnt(0)" ::: "memory");
        } else {
            XB_SPIN(xb_ld(&bar[XB_XGEN(b.x)]) == gen, bar);
            __builtin_amdgcn_fence(__ATOMIC_ACQUIRE, "agent");
            asm volatile("s_waitcnt vmcnt(0)" ::: "memory");
        }
    }
    __syncthreads();
}

#ifndef AMP_MASK
#define AMP_MASK 0
#endif
#ifndef AMP_K
#define AMP_K 1
#endif
#ifndef SYNC_REP
#define SYNC_REP 1
#endif
#define PH(id, ...) do { if ((AMP_MASK >> (id)) & 1) { const unsigned long long _t0 = __builtin_amdgcn_s_memrealtime(); __VA_ARGS__; __syncthreads(); \
    const unsigned long long _el = __builtin_amdgcn_s_memrealtime() - _t0; while (__builtin_amdgcn_s_memrealtime() - _t0 < _el * (1 + AMP_K)) __builtin_amdgcn_s_sleep(8); } else { __VA_ARGS__; } } while (0)
__device__ __forceinline__ void gsync_cg(cg::grid_group& grid) {
    asm volatile("s_waitcnt vmcnt(0) lgkmcnt(0)" ::: "memory");
    __threadfence();
    grid.sync();
    __threadfence();
}
#define gsync(grid) xcd_barrier(xbar)
template <class Epi>
__device__ __forceinline__ void run_gemm(LAS unsigned char* lds, const bf16* A, const bf16* Bt, int N, int K, const Epi& E, int G, int bid) {
    pg8::Gemm g{A, Bt, M, N, K}; pg8::StaticOrder S; S.init(M, N, G, bid);
    pg8::gemm_phase<Epi, pg8::StaticOrder, true, true>(lds, g, S, E);
}

__global__ void __launch_bounds__(512, 2) mk_fwd(Args a) {
    extern __shared__ __attribute__((aligned(16))) unsigned char lds_raw[];
    LAS unsigned char* lds = (LAS unsigned char*)lds_raw;
    cg::grid_group grid = cg::this_grid();
    const int tid = threadIdx.x, lane = tid & 63, wave = __builtin_amdgcn_readfirstlane(tid >> 6), bid = blockIdx.x, G = gridDim.x;
    unsigned char* ws = a.ws;
    bf16* H = (bf16*)(ws + WS_H);
    const float* MOD = (const float*)(ws + WS_MOD);

    if (bid == 0) for (int i = tid; i < XCD_BAR_WORDS; i += 512) ((unsigned*)ws)[i] = 0u;
    if (tid < 16) ((volatile LAS unsigned*)(lds + LDS_BYTES - 64))[tid] = 0u;
    asm volatile("s_waitcnt vmcnt(0) lgkmcnt(0)" ::: "memory");
    grid.sync();
    XcdBarrier xbar = xcd_barrier_post((unsigned*)ws, (volatile LAS unsigned*)(lds + LDS_BYTES - 64));
    PH(0, p0_phase(a, lds, bid, G, tid, lane, wave));
    gsync(grid);
    mod_finalize(a, bid, G, tid);
    PH(1, norm_phase<true>(a, lds, a.in[I_X], a.in[I_MIXNW], 0, 0, 1024, H, bid, G, tid, lane, wave));
    gsync(grid);
    { pg8::EpiBf16S<0> E{(bf16*)(ws + WS_Z), DIN, (bf16*)(ws + WS_XBC), NCV, DIN};
      PH(2, run_gemm(lds, H, (const bf16*)(ws + WS_WIN), 5120, D, E, G, bid)); }
    PH(4, dt_phase(a, bid, G, lane, wave));
    gsync(grid);
    PH(3, ssd_phase(a, lds, bid, G, tid, lane, wave));
    gsync(grid);
    PH(1, gnorm_phase(a, bid, G, lane, wave));
    gsync(grid);
    { pg8::EpiRes E{a.in[I_X], a.out, MOD + 2048};
      PH(2, run_gemm(lds, (const bf16*)(ws + WS_Z), (const bf16*)(ws + WS_WOUT), D, DIN, E, G, bid)); }
    gsync(grid);
    PH(1, norm_phase<false>(a, lds, a.out, a.in[I_MLPNW], 0, 3072, 4096, H, bid, G, tid, lane, wave));
    gsync(grid);
    { pg8::EpiBf16S<2> E{(bf16*)(ws + WS_ACT), DFF, (bf16*)(ws + WS_ACT), DFF, 1 << 30};
      PH(2, run_gemm(lds, H, (const bf16*)(ws + WS_WUP0), DFF, D, E, G, bid)); }
    gsync(grid);
    { pg8::EpiRes E{a.out, a.out, MOD + 5120};
      PH(2, run_gemm(lds, (const bf16*)(ws + WS_ACT), (const bf16*)(ws + WS_WDN0), D, DFF, E, G, bid)); }
    gsync(grid);
    PH(1, norm_phase<false>(a, lds, a.out, a.in[I_MIXNW] + D, 1, 0, 1024, H, bid, G, tid, lane, wave));
    gsync(grid);
    { pg8::EpiBf16S<0> E{(bf16*)(ws + WS_PROJ), NCV, (bf16*)(ws + WS_PROJ), NCV, 1 << 30};
      PH(2, run_gemm(lds, H, (const bf16*)(ws + WS_WSCIN), NCV, D, E, G, bid)); }
    gsync(grid);
    PH(1, sconv_phase(a, bid, G, lane, wave));
    gsync(grid);
    { pg8::EpiRes E{a.out, a.out, MOD + 8 * MODW + 2048};
      PH(2, run_gemm(lds, (const bf16*)(ws + WS_YSC), (const bf16*)(ws + WS_WSCOUT), D, D, E, G, bid)); }
    gsync(grid);
    PH(1, norm_phase<false>(a, lds, a.out, a.in[I_MLPNW] + D, 1, 3072, 4096, H, bid, G, tid, lane, wave));
    gsync(grid);
    { pg8::EpiBf16S<2> E{(bf16*)(ws + WS_ACT), DFF, (bf16*)(ws + WS_ACT), DFF, 1 << 30};
      PH(2, run_gemm(lds, H, (const bf16*)(ws + WS_WUP1), DFF, D, E, G, bid)); }
    gsync(grid);
    { pg8::EpiRes E{a.out, a.out, MOD + 8 * MODW + 5120};
      PH(2, run_gemm(lds, (const bf16*)(ws + WS_ACT), (const bf16*)(ws + WS_WDN1), D, DFF, E, G, bid)); }
    gsync(grid);
    PH(1, fnorm_phase(a, bid, G, lane, wave));
}

extern "C" void kernel_launch(void* const* d_in, const int* in_sizes, int n_in, void* d_out, int out_size, void* d_ws, size_t ws_size, hipStream_t stream) {
    static int grid = 0;
    if (grid == 0) {
        if (n_in != 20 || in_sizes[0] != M * D || out_size != M * D || ws_size < WS_END) { fprintf(stderr, "kernel_launch: unexpected shapes (n_in %d, in0 %d, out %d, ws %zu)\n", n_in, n_in > 0 ? in_sizes[0] : -1, out_size, ws_size); grid = -1; return; }
        int dev = 0, cus = 0, per_cu = 0;
        hipGetDevice(&dev); hipDeviceGetAttribute(&cus, hipDeviceAttributeMultiprocessorCount, dev);
        if (hipFuncSetAttribute((const void*)mk_fwd, hipFuncAttributeMaxDynamicSharedMemorySize, LDS_BYTES) != hipSuccess) { fprintf(stderr, "kernel_launch: hipFuncSetAttribute failed\n"); grid = -1; return; }
        if (hipOccupancyMaxActiveBlocksPerMultiprocessor(&per_cu, (const void*)mk_fwd, 512, LDS_BYTES) != hipSuccess || per_cu < 1) { fprintf(stderr, "kernel_launch: occupancy query says %d blocks per CU\n", per_cu); (void)hipGetLastError(); per_cu = 1; }
        grid = cus;
        if (grid <= 0) { grid = -1; return; }
    }
    if (grid < 0) return;
    Args a{};
    for (int i = 0; i < 20; ++i) a.in[i] = (const float*)d_in[i];
    a.out = (float*)d_out; a.ws = (unsigned char*)d_ws;
    void* args[] = {&a};
    hipError_t e = hipLaunchCooperativeKernel((const void*)mk_fwd, dim3(grid), dim3(512), args, LDS_BYTES, stream);
    if (e != hipSuccess) fprintf(stderr, "cooperative launch failed: %s (grid %d)\n", hipGetErrorString(e), grid);
}
```

```cpp
#include <hip/hip_runtime.h>
#include <hip/hip_cooperative_groups.h>
#include <cstdio>
#include <cstdint>
namespace cg = cooperative_groups;
namespace pg8 {
#define PG8_LAS __attribute__((address_space(3)))
typedef unsigned short bf16_t;
typedef short bf16x8 __attribute__((ext_vector_type(8)));
typedef float f32x4 __attribute__((ext_vector_type(4)));
typedef unsigned u32x4 __attribute__((ext_vector_type(4)));
constexpr int BM = 256, BK = 64, HALF = 128, HTB = HALF * BK * 2  , STAGE_BYTES = 8 * HTB, NXCD = 8, WGM = 8;

__host__ __device__ __forceinline__ int lds_byte(int r, int c) { const int st = (r >> 4) * 2 + (c >> 5), rr = r & 15, cc = c & 31, ob = rr * 64 + cc * 2; return st * 1024 + (ob ^ (((ob >> 9) & 1) << 5)); }
__host__ __device__ __forceinline__ void stage_rc(int b, int& R, int& C) { const int st = b / 1024, sb = b % 1024, swz = sb ^ (((sb >> 9) & 1) << 5); R = (st >> 1) * 16 + swz / 64; C = (st & 1) * 32 + (swz % 64) / 2; }
__host__ __device__ __forceinline__ int perm32(int rho) { const int n = rho >> 4, i = rho & 15; return 8 * (i >> 2) + 4 * n + (i & 3); }

struct Unit { int pm, pn; };
struct Gemm { const bf16_t* A; const bf16_t* Bt; int M, N, K; };

struct StaticOrder {
    int nM, nN, nwg, G, c;
    __host__ __device__ void init(int M, int N, int G_, int c_) { nM = M / BM; nN = N / BM; nwg = nM * nN; G = G_; c = c_; }
    __host__ __device__ bool next(int i, Unit& u) const {
        const long L = (long)i * G + c; if (L >= nwg) return false;
        int wgid = (int)L; { const int q = nwg / NXCD, r = nwg % NXCD, xcd = wgid % NXCD, off = wgid / NXCD; wgid = (xcd < r ? xcd * (q + 1) : r * (q + 1) + (xcd - r) * q) + off; }
        const int nig = WGM * nN, gid = wgid / nig, fm = gid * WGM, gsz = (nM - fm) < WGM ? (nM - fm) : WGM;
        u.pm = fm + ((wgid % nig) % gsz); u.pn = (wgid % nig) / gsz; return true;
    }
    __device__ __forceinline__ void a_ready(const Unit&) const {}
    __device__ __forceinline__ void done(const Unit&) const {}
};
__device__ __forceinline__ unsigned cvt_pk_bf16(float lo, float hi) { unsigned r; asm volatile("v_cvt_pk_bf16_f32 %0, %1, %2" : "=v"(r) : "v"(lo), "v"(hi)); return r; }
typedef float f32x2 __attribute__((ext_vector_type(2)));
__device__ __forceinline__ unsigned pk2bf(float lo, float hi) { unsigned r; asm("v_cvt_pk_bf16_f32 %0, %1, %2" : "=v"(r) : "v"(lo), "v"(hi)); return r; }
template <int ACT  > struct EpiBf16S {
    static constexpr bool PERM = true, AFTER_DRAIN = false;
    bf16_t* O0; int ld0; bf16_t* O1; int ld1; int csplit;
    __device__ __forceinline__ void operator()(const f32x4 (&acc)[2][2][4][2], const Unit& u, int wr, int wc, int fr, int fq) const {
        const int row0 = u.pm * BM + wr * 64 + fr; int colt = u.pn * BM; bf16_t* base = O0; int ldc = ld0;
        if (colt >= csplit) { base = O1; ldc = ld1; colt -= csplit; }
        const int col0 = colt + wc * 32 + 8 * fq;
#pragma unroll
        for (int ai = 0; ai < 2; ++ai)
#pragma unroll
            for (int m = 0; m < 4; ++m) { bf16_t* rowp = base + (size_t)(row0 + ai * HALF + m * 16) * ldc + col0;
#pragma unroll
                for (int bj = 0; bj < 2; ++bj) { f32x4 v0 = acc[ai][bj][m][0], v1 = acc[ai][bj][m][1];
                    if (ACT == 2) {
#pragma unroll
                        for (int e = 0; e < 4; ++e) { float a0 = fmaxf(v0[e], 0.f), a1 = fmaxf(v1[e], 0.f); v0[e] = a0 * a0; v1[e] = a1 * a1; } }
                    u32x4 w; w.x = pk2bf(v0[0], v0[1]); w.y = pk2bf(v0[2], v0[3]); w.z = pk2bf(v1[0], v1[1]); w.w = pk2bf(v1[2], v1[3]);
                    *(u32x4*)(rowp + bj * HALF) = w; } }
    }
};
struct EpiRes {
    static constexpr bool PERM = false, AFTER_DRAIN = false;
    const float* base; float* out; const float* gate;
    __device__ __forceinline__ void operator()(const f32x4 (&acc)[2][2][4][2], const Unit& u, int wr, int wc, int fr, int fq) const {
        const int b = (u.pm * BM) >> 11; const float* gp = gate + (size_t)b * 6144;
        const int col0 = u.pn * BM + wc * 32 + 4 * fq;
        f32x4 gv[2][2];
#pragma unroll
        for (int bj = 0; bj < 2; ++bj)
#pragma unroll
            for (int n = 0; n < 2; ++n) gv[bj][n] = *(const f32x4*)(gp + col0 + bj * HALF + n * 16);
#pragma unroll
        for (int ai = 0; ai < 2; ++ai)
#pragma unroll
            for (int m = 0; m < 4; ++m) { const size_t off = (size_t)(u.pm * BM + ai * HALF + wr * 64 + m * 16 + fr) * 1024 + col0;
#pragma unroll
                for (int bj = 0; bj < 2; ++bj)
#pragma unroll
                    for (int n = 0; n < 2; ++n) { const f32x4 bs = *(const f32x4*)(base + off + bj * HALF + n * 16);
                        *(f32x4*)(out + off + bj * HALF + n * 16) = bs + gv[bj][n] * acc[ai][bj][m][n]; }
                asm volatile("" ::: "memory"); }
    }
};

template <class Epi, class Sched, bool ALIGN_EPI = false, bool SP2 = false>
__device__ __forceinline__ void gemm_phase(PG8_LAS unsigned char* lds, const Gemm g, const Sched& S, const Epi& E) {
    int tid_ = threadIdx.x; asm volatile("" : "+v"(tid_));
    const int tid = tid_, wid = __builtin_amdgcn_readfirstlane(tid >> 6), lane = tid & 63, wr = wid >> 2, wc = wid & 3, fr = lane & 15, fq = lane >> 4;
    const int K = g.K, nt = K / BK;
    unsigned voffA[2], voffB[2];
#pragma unroll
    for (int i = 0; i < 2; ++i) { int R, C; stage_rc(tid * 16 + i * 8192, R, C); const int Rb = Epi::PERM ? ((R & ~31) + perm32(R & 31)) : R;
        voffA[i] = (unsigned)(R * K + C) * 2u; voffB[i] = (unsigned)(Rb * K + C) * 2u; }
    const size_t kstep = (size_t)(BK * 2);
    const size_t hstep = (size_t)HALF * K * 2;
    const size_t tstep = 2 * hstep;
    const unsigned ldsw = (unsigned)wid * 1024u;
    const int aoff = lds_byte(wr * 64 + fr, fq * 8), boff = lds_byte(wc * 32 + fr, fq * 8);
#define PG8_SA(b, h) (((b) * 2 + (h)) * HTB)
#define PG8_SB(b, h) ((4 + (b) * 2 + (h)) * HTB)
#define PG8_STAGE(bufoff, gbase, voff) do { _Pragma("unroll") for (int _i = 0; _i < 2; ++_i) \
        __builtin_amdgcn_global_load_lds((const unsigned*)((const char*)(gbase) + (voff)[_i]), (PG8_LAS unsigned*)(lds + (bufoff) + ldsw + _i * 8192), 16, 0, 0); } while (0)
#define PG8_LDA(dst, b, h) do { _Pragma("unroll") for (int m = 0; m < 4; ++m) _Pragma("unroll") for (int k = 0; k < 2; ++k) dst[m][k] = *(const PG8_LAS bf16x8*)(lds + PG8_SA(b, h) + aoff + m * 2048 + k * 1024); } while (0)
#define PG8_LDB(dst, b, h) do { _Pragma("unroll") for (int n = 0; n < 2; ++n) _Pragma("unroll") for (int k = 0; k < 2; ++k) dst[n][k] = *(const PG8_LAS bf16x8*)(lds + PG8_SB(b, h) + boff + n * 2048 + k * 1024); } while (0)
#define PG8_MMA(ai, bj, At, Bt) do { __builtin_amdgcn_s_setprio(1); _Pragma("unroll") for (int m = 0; m < 4; ++m) _Pragma("unroll") for (int n = 0; n < 2; ++n) _Pragma("unroll") for (int k = 0; k < 2; ++k) \
        acc[ai][bj][m][n] = __builtin_amdgcn_mfma_f32_16x16x32_bf16(Bt[n][k], At[m][k], acc[ai][bj][m][n], 0, 0, 0); __builtin_amdgcn_s_setprio(0); } while (0)
#define PG8_WAIT_V(n) asm volatile("s_waitcnt vmcnt(" #n ")" ::: "memory")
#define PG8_WAIT_L(n) asm volatile("s_waitcnt lgkmcnt(" #n ")" ::: "memory")
#define PG8_BAR __builtin_amdgcn_s_barrier()
#define PG8_SCHED __builtin_amdgcn_sched_barrier(0)
    Unit cur, nxt; int ui = 0;
    if (!S.next(0, cur)) return;
    f32x4 acc[2][2][4][2];
#pragma unroll
    for (int a = 0; a < 2; ++a)
#pragma unroll
        for (int b = 0; b < 2; ++b)
#pragma unroll
            for (int m = 0; m < 4; ++m)
#pragma unroll
                for (int n = 0; n < 2; ++n) acc[a][b][m][n] = (f32x4){0.f, 0.f, 0.f, 0.f};
    bf16x8 At[4][2], B0[2][2], B1[2][2];
    const char* cA = (const char*)g.A + (size_t)cur.pm * tstep; const char* cB = (const char*)g.Bt + (size_t)cur.pn * tstep;
    S.a_ready(cur);
    if constexpr (SP2) {
        PG8_STAGE(PG8_SB(0, 0), cB, voffB); PG8_STAGE(PG8_SB(0, 1), cB + hstep, voffB); PG8_STAGE(PG8_SA(0, 0), cA, voffA); PG8_STAGE(PG8_SA(0, 1), cA + hstep, voffA);
        if (wr == 1) PG8_BAR;
        PG8_WAIT_V(2); PG8_BAR;
        PG8_STAGE(PG8_SB(1, 0), cB + kstep, voffB); PG8_STAGE(PG8_SA(1, 0), cA + kstep, voffA); PG8_STAGE(PG8_SB(1, 1), cB + hstep + kstep, voffB);
        PG8_WAIT_V(6); PG8_BAR;
    } else {
        PG8_STAGE(PG8_SB(0, 0), cB, voffB); PG8_STAGE(PG8_SA(0, 0), cA, voffA); PG8_STAGE(PG8_SB(0, 1), cB + hstep, voffB); PG8_STAGE(PG8_SA(0, 1), cA + hstep, voffA);
        if (wr == 1) PG8_BAR;
        PG8_WAIT_V(4); PG8_BAR;
        PG8_STAGE(PG8_SB(1, 0), cB + kstep, voffB); PG8_STAGE(PG8_SA(1, 0), cA + kstep, voffA); PG8_STAGE(PG8_SB(1, 1), cB + hstep + kstep, voffB);
        PG8_WAIT_V(6); PG8_BAR;
    }
    for (;;) {
        const bool has_next = S.next(ui + 1, nxt);
        const char* nA = has_next ? (const char*)g.A + (size_t)nxt.pm * tstep : cA; const char* nB = has_next ? (const char*)g.Bt + (size_t)nxt.pn * tstep : cB;
        for (int t = 0; t < nt; t += 2) {
            const bool last = (t == nt - 2);
            const char* a1 = cA + (size_t)(t + 1) * kstep;
            const char* a2 = last ? nA : cA + (size_t)(t + 2) * kstep; const char* b2 = last ? nB : cB + (size_t)(t + 2) * kstep;
            const char* a3 = a2 + kstep; const char* b3 = b2 + kstep;
            if (last && has_next) S.a_ready(nxt);
            if constexpr (SP2) {
            PG8_LDB(B0, 0, 0); PG8_LDB(B1, 0, 1); PG8_SCHED; PG8_LDA(At, 0, 0); PG8_STAGE(PG8_SA(1, 1), a1 + hstep, voffA);
            PG8_WAIT_V(8); PG8_WAIT_L(0); PG8_BAR; PG8_MMA(0, 0, At, B0); PG8_MMA(0, 1, At, B1); PG8_BAR; PG8_SCHED;
            PG8_LDA(At, 0, 1); PG8_STAGE(PG8_SB(0, 0), b2, voffB); PG8_STAGE(PG8_SB(0, 1), b2 + hstep, voffB); PG8_STAGE(PG8_SA(0, 0), a2, voffA);
            PG8_WAIT_V(8); PG8_WAIT_L(0); PG8_BAR; PG8_MMA(1, 0, At, B0); PG8_MMA(1, 1, At, B1); PG8_BAR; PG8_SCHED;
            PG8_LDB(B0, 1, 0); PG8_LDB(B1, 1, 1); PG8_SCHED; PG8_LDA(At, 1, 0); PG8_STAGE(PG8_SA(0, 1), a2 + hstep, voffA);
            PG8_WAIT_V(8); PG8_WAIT_L(0); PG8_BAR; PG8_MMA(0, 0, At, B0); PG8_MMA(0, 1, At, B1); PG8_BAR; PG8_SCHED;
            PG8_LDA(At, 1, 1); PG8_STAGE(PG8_SB(1, 0), b3, voffB); PG8_STAGE(PG8_SB(1, 1), b3 + hstep, voffB); PG8_STAGE(PG8_SA(1, 0), a3, voffA);
            PG8_WAIT_V(8); PG8_WAIT_L(0); PG8_BAR; PG8_MMA(1, 0, At, B0); PG8_MMA(1, 1, At, B1); PG8_BAR; PG8_SCHED;
            } else {
            PG8_LDB(B0, 0, 0); PG8_SCHED; PG8_LDA(At, 0, 0); PG8_STAGE(PG8_SA(1, 1), a1 + hstep, voffA);
            PG8_WAIT_L(8); PG8_BAR; PG8_WAIT_L(0); PG8_MMA(0, 0, At, B0); PG8_BAR; PG8_SCHED;
            PG8_LDB(B1, 0, 1); PG8_STAGE(PG8_SB(0, 0), b2, voffB);
            PG8_BAR; PG8_WAIT_L(0); PG8_MMA(0, 1, At, B1); PG8_BAR;
            PG8_LDA(At, 0, 1); PG8_STAGE(PG8_SA(0, 0), a2, voffA);
            PG8_BAR; PG8_WAIT_L(0); PG8_MMA(1, 0, At, B0); PG8_BAR; PG8_SCHED;
            PG8_STAGE(PG8_SB(0, 1), b2 + hstep, voffB);
            PG8_WAIT_V(6); PG8_BAR; PG8_MMA(1, 1, At, B1); PG8_BAR;
            PG8_LDB(B0, 1, 0); PG8_SCHED; PG8_LDA(At, 1, 0); PG8_STAGE(PG8_SA(0, 1), a2 + hstep, voffA);
            PG8_WAIT_L(8); PG8_BAR; PG8_WAIT_L(0); PG8_MMA(0, 0, At, B0); PG8_BAR; PG8_SCHED;
            PG8_LDB(B1, 1, 1); PG8_STAGE(PG8_SB(1, 0), b3, voffB);
            PG8_BAR; PG8_WAIT_L(0); PG8_MMA(0, 1, At, B1); PG8_BAR;
            PG8_LDA(At, 1, 1); PG8_STAGE(PG8_SA(1, 0), a3, voffA);
            PG8_BAR; PG8_WAIT_L(0); PG8_MMA(1, 0, At, B0); PG8_BAR; PG8_SCHED;
            PG8_STAGE(PG8_SB(1, 1), b3 + hstep, voffB);
            PG8_WAIT_V(6); PG8_BAR; PG8_MMA(1, 1, At, B1); PG8_BAR;
            }
        }
        if constexpr (ALIGN_EPI) { if (wr == 0) PG8_BAR; }
        if constexpr (!Epi::AFTER_DRAIN) { E(acc, cur, wr, wc, fr, fq); S.done(cur); }
        if (!has_next) break;
#pragma unroll
        for (int a = 0; a < 2; ++a)
#pragma unroll
            for (int b = 0; b < 2; ++b)
#pragma unroll
                for (int m = 0; m < 4; ++m)
#pragma unroll
                    for (int n = 0; n < 2; ++n) acc[a][b][m][n] = (f32x4){0.f, 0.f, 0.f, 0.f};
        cur = nxt; cA = nA; cB = nB; ++ui;
        if constexpr (ALIGN_EPI) { if (wr == 1) PG8_BAR; }
    }
    PG8_WAIT_V(0);
    if constexpr (!ALIGN_EPI) { if (wr == 0) PG8_BAR; }
    PG8_BAR;
    if constexpr (Epi::AFTER_DRAIN) { E.fused(acc, cur, wr, wc, fr, fq, lds, wid, lane); S.done(cur); }
#undef PG8_SA
#undef PG8_SB
#undef PG8_STAGE
#undef PG8_LDA
#undef PG8_LDB
#undef PG8_MMA
#undef PG8_WAIT_V
#undef PG8_WAIT_L
#undef PG8_BAR
#undef PG8_SCHED
}
}
constexpr int SEQ = 2048, BATCH = 8, M = BATCH * SEQ, D = 1024, DFF = 4096, DIN = 2048, NCV = 3072, NH = 32, NIN = 5152, MODW = 6144;
constexpr float EPS = 1e-5f;
constexpr size_t MiB = 1u << 20;
constexpr size_t WS_MODP = 1 * MiB;
constexpr size_t WS_MOD = 2 * MiB + 512 * 1024;
constexpr size_t WS_WIN = 3 * MiB, WS_WOUT = 14 * MiB, WS_WUP0 = 18 * MiB, WS_WUP1 = 26 * MiB, WS_WDN0 = 34 * MiB, WS_WDN1 = 42 * MiB, WS_WSCIN = 50 * MiB, WS_WSCOUT = 56 * MiB;
constexpr size_t WS_DT = 58 * MiB, WS_SS = 60 * MiB, WS_H = 62 * MiB, WS_Z = 94 * MiB, WS_XBC = 158 * MiB, WS_END = 254 * MiB;
constexpr size_t WS_ACT = WS_Z, WS_PROJ = WS_Z, WS_YSC = WS_Z + 96 * MiB;
constexpr int LDS_BYTES = 147456;

#define LAS __attribute__((address_space(3)))
typedef unsigned short bf16;
typedef unsigned u32x4 __attribute__((ext_vector_type(4)));
typedef unsigned u32x2 __attribute__((ext_vector_type(2)));
typedef float f32x4 __attribute__((ext_vector_type(4)));
typedef short bf16x8 __attribute__((ext_vector_type(8)));

__device__ __forceinline__ unsigned pk2(float lo, float hi) { unsigned r; asm("v_cvt_pk_bf16_f32 %0, %1, %2" : "=v"(r) : "v"(lo), "v"(hi)); return r; }
__device__ __forceinline__ float bflo(unsigned w) { return __uint_as_float(w << 16); }
__device__ __forceinline__ float bfhi(unsigned w) { return __uint_as_float(w & 0xffff0000u); }
__device__ __forceinline__ float bf1(bf16 v) { return __uint_as_float(((unsigned)v) << 16); }
__device__ __forceinline__ float fexp(float x) { return __builtin_amdgcn_exp2f(x * 1.4426950408889634f); }
__device__ __forceinline__ float silu_f(float v) { return v * __builtin_amdgcn_rcpf(1.0f + fexp(-v)); }
__device__ __forceinline__ float wave_sum(float v) {
#pragma unroll
    for (int o = 1; o < 64; o <<= 1) v += __shfl_xor(v, o);
    return v;
}
#define LDS_WAIT() asm volatile("s_waitcnt lgkmcnt(0)" ::: "memory")

struct Args { const float* in[20]; float* out; unsigned char* ws; };
enum { I_X = 0, I_C, I_ADAW, I_ADAB, I_MIXNW, I_MLPNW, I_UP, I_DOWN, I_SSDIN, I_SSDCW, I_SSDCB, I_DTB, I_ALOG, I_DSK, I_SSDNW, I_SSDOUT, I_SCIN, I_SCCW, I_SCOUT, I_FNW };

__device__ __forceinline__ void transpose_item(const float* W, int K, int N, bf16* WT, LAS float* scr, int item, int lane) {
    const int nblk = N / 32, kb = item / nblk, nb = item % nblk, k0 = 64 * kb, n0 = 32 * nb;
#pragma unroll 8
    for (int i = 0; i < 32; ++i) { const int kk = 2 * i + (lane >> 5); scr[kk * 33 + (lane & 31)] = W[(size_t)(k0 + kk) * N + n0 + (lane & 31)]; }
    LDS_WAIT(); asm volatile("" ::: "memory");
    const int c = lane & 7;
#pragma unroll
    for (int j = 0; j < 4; ++j) { const int n = (lane >> 3) + 8 * j; const LAS float* s = scr + (8 * c) * 33 + n;
        u32x4 o; o.x = pk2(s[0 * 33], s[1 * 33]); o.y = pk2(s[2 * 33], s[3 * 33]); o.z = pk2(s[4 * 33], s[5 * 33]); o.w = pk2(s[6 * 33], s[7 * 33]);
        *(u32x4*)(WT + (size_t)(n0 + n) * K + k0 + 8 * c) = o; }
    LDS_WAIT(); asm volatile("" ::: "memory");
}

__device__ __forceinline__ void p0_phase(const Args& a, LAS unsigned char* lds, int bid, int G, int tid, int lane, int wave) {
    unsigned char* ws = a.ws;
    LAS float* cond = (LAS float*)lds;
    LAS float* red = (LAS float*)(lds + 32768);
    const float* cin = a.in[I_C];
    for (int i = tid; i < 8192; i += 512) cond[i] = silu_f(cin[i]);
    __syncthreads();
    float* modp = (float*)(ws + WS_MODP);
    for (int it = bid; it < 768; it += G) {
        const int i = it / 384, r = it % 384, cb = r >> 2, ks = r & 3, n0 = cb * 64, k0 = ks * 256 + wave * 32;
        const float* wp = a.in[I_ADAW] + ((size_t)i * 1024 + k0) * MODW + n0 + lane;
        float acc[8];
#pragma unroll
        for (int b = 0; b < 8; ++b) acc[b] = 0.f;
#pragma unroll 8
        for (int kk = 0; kk < 32; ++kk) { const float wv = wp[(size_t)kk * MODW];
#pragma unroll
            for (int b = 0; b < 8; ++b) acc[b] += cond[b * 1024 + k0 + kk] * wv; }
#pragma unroll
        for (int b = 0; b < 8; ++b) red[(wave * 8 + b) * 64 + lane] = acc[b];
        __syncthreads();
        { const int b = tid >> 6; float s = 0.f;
#pragma unroll
          for (int w = 0; w < 8; ++w) s += red[(w * 8 + b) * 64 + lane];
          modp[(size_t)((ks * 2 + i) * 8 + b) * MODW + n0 + lane] = s; }
        __syncthreads();
    }
    LAS float* scr = (LAS float*)(lds + wave * 16384);
    const int gw = bid * 8 + wave, NGW = G * 8;
    constexpr int I0 = 16 * 161, I1 = 32 * 32, I2 = 16 * 128, I4 = 64 * 32, I6 = 16 * 96, I7 = 16 * 32;
    constexpr int NITEMS = I0 + I1 + 2 * I2 + 2 * I4 + I6 + I7;
    for (int it = gw; it < NITEMS; it += NGW) {
        int r = it;
        if (r < I0) { transpose_item(a.in[I_SSDIN], D, NIN, (bf16*)(ws + WS_WIN), scr, r, lane); continue; } r -= I0;
        if (r < I1) { transpose_item(a.in[I_SSDOUT], DIN, D, (bf16*)(ws + WS_WOUT), scr, r, lane); continue; } r -= I1;
        if (r < I2) { transpose_item(a.in[I_UP], D, DFF, (bf16*)(ws + WS_WUP0), scr, r, lane); continue; } r -= I2;
        if (r < I2) { transpose_item(a.in[I_UP] + (size_t)D * DFF, D, DFF, (bf16*)(ws + WS_WUP1), scr, r, lane); continue; } r -= I2;
        if (r < I4) { transpose_item(a.in[I_DOWN], DFF, D, (bf16*)(ws + WS_WDN0), scr, r, lane); continue; } r -= I4;
        if (r < I4) { transpose_item(a.in[I_DOWN] + (size_t)D * DFF, DFF, D, (bf16*)(ws + WS_WDN1), scr, r, lane); continue; } r -= I4;
        if (r < I6) { transpose_item(a.in[I_SCIN], D, 3 * D, (bf16*)(ws + WS_WSCIN), scr, r, lane); continue; } r -= I6;
        transpose_item(a.in[I_SCOUT], D, D, (bf16*)(ws + WS_WSCOUT), scr, r, lane);
    }
}

template <bool PART>
__device__ __forceinline__ void norm_phase(const Args& a, LAS unsigned char* lds, const float* src, const float* gw, int layer, int off_sh, int off_sc, bf16* dst,
                                           int bid, int G, int tid, int lane, int wave) {
    LAS float* Aw = (LAS float*)lds; LAS float* Sw = (LAS float*)(lds + 4096);
    const float* modp = (const float*)(a.ws + WS_MODP); const float* mod = (const float*)(a.ws + WS_MOD);
    for (int ck = bid; ck < 256; ck += G) {
        const int row0 = ck * 64, b = row0 >> 11;
        __syncthreads();
        for (int k = tid; k < 1024; k += 512) {
            float sc, sh;
            if (PART) { sc = a.in[I_ADAB][layer * MODW + off_sc + k]; sh = a.in[I_ADAB][layer * MODW + off_sh + k];
#pragma unroll
                for (int ks = 0; ks < 4; ++ks) { const float* p = modp + (size_t)((ks * 2 + layer) * 8 + b) * MODW; sc += p[off_sc + k]; sh += p[off_sh + k]; } }
            else { const float* p = mod + (size_t)(layer * 8 + b) * MODW; sc = p[off_sc + k]; sh = p[off_sh + k]; }
            Aw[k] = gw[k] * (1.0f + sc); Sw[k] = sh; }
        __syncthreads();
        for (int rr = wave; rr < 64; rr += 8) {
            const int row = row0 + rr;
            const f32x4* xr = (const f32x4*)(src + (size_t)row * D) + lane;
            f32x4 v[4]; float s = 0.f;
#pragma unroll
            for (int j = 0; j < 4; ++j) { v[j] = xr[64 * j]; s += (v[j].x * v[j].x + v[j].y * v[j].y) + (v[j].z * v[j].z + v[j].w * v[j].w); }
            const float rstd = __builtin_amdgcn_rsqf(wave_sum(s) * (1.f / D) + EPS);
            u32x2* o8 = (u32x2*)(dst + (size_t)row * D) + lane;
#pragma unroll
            for (int j = 0; j < 4; ++j) { const f32x4 aw = *(const LAS f32x4*)(Aw + 4 * lane + 256 * j), sw = *(const LAS f32x4*)(Sw + 4 * lane + 256 * j);
                const f32x4 o = v[j] * rstd * aw + sw; u32x2 w; w.x = pk2(o.x, o.y); w.y = pk2(o.z, o.w); o8[64 * j] = w; }
        }
    }
}
__device__ __forceinline__ void mod_finalize(const Args& a, int bid, int G, int tid) {
    const float* modp = (const float*)(a.ws + WS_MODP); float* mod = (float*)(a.ws + WS_MOD);
    for (int idx = bid * 512 + tid; idx < 2 * 8 * MODW; idx += G * 512) {
        const int i = idx / (8 * MODW), rem = idx % (8 * MODW), j = rem % MODW;
        float v = a.in[I_ADAB][i * MODW + j];
#pragma unroll
        for (int ks = 0; ks < 4; ++ks) v += modp[(size_t)(ks * 2 + i) * (8 * MODW) + rem];
        mod[idx] = v; }
}

__device__ __forceinline__ void dt_phase(const Args& a, int bid, int G, int lane, int wave) {
    const bf16* H = (const bf16*)(a.ws + WS_H); const bf16* WT = (const bf16*)(a.ws + WS_WIN); float* DT = (float*)(a.ws + WS_DT);
    const int fr = lane & 15, fq = lane >> 4;
    const f32x4 bias0 = *(const f32x4*)(a.in[I_DTB] + 4 * fq), bias1 = *(const f32x4*)(a.in[I_DTB] + 16 + 4 * fq);
    for (int it = bid * 8 + wave; it < M / 16; it += G * 8) {
        const int m0 = it * 16;
        const bf16* ap = H + (size_t)(m0 + fr) * D + 8 * fq;
        const bf16* bp0 = WT + (size_t)(5120 + fr) * D + 8 * fq; const bf16* bp1 = bp0 + (size_t)16 * D;
        f32x4 acc0 = {0.f, 0.f, 0.f, 0.f}, acc1 = {0.f, 0.f, 0.f, 0.f};
#pragma unroll 4
        for (int k0 = 0; k0 < D; k0 += 32) {
            const bf16x8 av = *(const bf16x8*)(ap + k0), b0 = *(const bf16x8*)(bp0 + k0), b1 = *(const bf16x8*)(bp1 + k0);
            acc0 = __builtin_amdgcn_mfma_f32_16x16x32_bf16(b0, av, acc0, 0, 0, 0);
            acc1 = __builtin_amdgcn_mfma_f32_16x16x32_bf16(b1, av, acc1, 0, 0, 0); }
        f32x4 o0, o1;
#pragma unroll
        for (int j = 0; j < 4; ++j) { const float x0 = acc0[j] + bias0[j], x1 = acc1[j] + bias1[j];
            o0[j] = fmaxf(x0, 0.f) + log1pf(expf(-fabsf(x0))); o1[j] = fmaxf(x1, 0.f) + log1pf(expf(-fabsf(x1))); }
        *(f32x4*)(DT + (size_t)(m0 + fr) * NH + 4 * fq) = o0; *(f32x4*)(DT + (size_t)(m0 + fr) * NH + 16 + 4 * fq) = o1;
    }
}
__device__ __forceinline__ void bcconv_phase(const Args& a, int bid, int G, int lane, int wave) {
    const bf16* XBC = (const bf16*)(a.ws + WS_XBC); bf16* BC = (bf16*)(a.ws + WS_H);
    for (int it = bid * 8 + wave; it < 2048; it += G * 8) {
        const int seg = it >> 1, col = (it & 1) * 512 + lane * 8, row0 = seg * 16;
        float w[5][8];
#pragma unroll
        for (int k = 0; k < 5; ++k) { const float* wp = (k < 4 ? a.in[I_SSDCW] + k * NCV : a.in[I_SSDCB]) + 2048 + col; const f32x4 a0 = *(const f32x4*)wp, a1 = *(const f32x4*)(wp + 4);
            w[k][0] = a0.x; w[k][1] = a0.y; w[k][2] = a0.z; w[k][3] = a0.w; w[k][4] = a1.x; w[k][5] = a1.y; w[k][6] = a1.z; w[k][7] = a1.w; }
        u32x4 r3 = {0u, 0u, 0u, 0u}, r2 = r3, r1 = r3;
        const bf16* src = XBC + (size_t)row0 * NCV + 2048 + col;
        if ((row0 & (SEQ - 1)) != 0) { r3 = *(const u32x4*)(src - 3 * NCV); r2 = *(const u32x4*)(src - 2 * NCV); r1 = *(const u32x4*)(src - NCV); }
#pragma unroll 4
        for (int r = 0; r < 16; ++r) {
            const u32x4 r0 = *(const u32x4*)(src + (size_t)r * NCV);
            float y[8];
#pragma unroll
            for (int q = 0; q < 4; ++q) {
                y[2 * q] = silu_f(w[4][2 * q] + w[0][2 * q] * bflo(r3[q]) + w[1][2 * q] * bflo(r2[q]) + w[2][2 * q] * bflo(r1[q]) + w[3][2 * q] * bflo(r0[q]));
                y[2 * q + 1] = silu_f(w[4][2 * q + 1] + w[0][2 * q + 1] * bfhi(r3[q]) + w[1][2 * q + 1] * bfhi(r2[q]) + w[2][2 * q + 1] * bfhi(r1[q]) + w[3][2 * q + 1] * bfhi(r0[q])); }
            *(u32x4*)(BC + (size_t)(row0 + r) * D + col) = (u32x4){pk2(y[0], y[1]), pk2(y[2], y[3]), pk2(y[4], y[5]), pk2(y[6], y[7])};
            r3 = r2; r2 = r1; r1 = r0;
        }
    }
}

constexpr int RSB = 272;
constexpr int S_BM = 0, S_CM = 34816, S_BDT = 69632, S_XDT = 104448, S_ST = 121856, S_ACS = 139264, S_DTV = 139776, S_CW = 140288;
static_assert(S_CW + 5 * 320 * 4 <= LDS_BYTES, "SSD LDS map");
__device__ __forceinline__ float wave_scan_incl(float v, int lane) {
#pragma unroll
    for (int o = 1; o < 64; o <<= 1) { const float t = __shfl_up(v, o); if (lane >= o) v += t; }
    return v;
}
template <int NR>
__device__ __forceinline__ void conv_col(const u32x4 (&raw)[NR + 3], int j, const LAS float* cw, float (&o)[NR]) {
    float rf[NR + 3];
#pragma unroll
    for (int i = 0; i < NR + 3; ++i) { const unsigned w = raw[i][j >> 1]; rf[i] = (j & 1) ? bfhi(w) : bflo(w); }
    const float w0 = cw[j], w1 = cw[320 + j], w2 = cw[640 + j], w3 = cw[960 + j], bb = cw[1280 + j];
#pragma unroll
    for (int i = 0; i < NR; ++i) o[i] = silu_f(bb + w0 * rf[i] + w1 * rf[i + 1] + w2 * rf[i + 2] + w3 * rf[i + 3]);
}
__device__ __forceinline__ void ssd_phase(const Args& a, LAS unsigned char* lds, int bid, int G, int tid, int lane, int wave) {
    const bf16* XBC = (const bf16*)(a.ws + WS_XBC); bf16* Z = (bf16*)(a.ws + WS_Z); const float* DT = (const float*)(a.ws + WS_DT); float* SS = (float*)(a.ws + WS_SS);
    const int fr = lane & 15, fq = lane >> 4;
    LAS float* Acs = (LAS float*)(lds + S_ACS); LAS float* dtv = (LAS float*)(lds + S_DTV); LAS float* CW = (LAS float*)(lds + S_CW);
    for (int item = bid; item < 256; item += G) {
        const int xcd = item & 7, jj = item >> 3, pg = xcd * 4 + (jj >> 3), hh = jj & 7, b = pg >> 2, g = pg & 3, h = g * 8 + hh;
        const float A_h = -expf(a.in[I_ALOG][h]), D_h = a.in[I_DSK][h];
        __syncthreads();
        for (int i = tid; i < 5 * 320; i += 512) { const int k = i / 320, cl = i % 320;
            const int ch = cl < 64 ? h * 64 + cl : (cl < 192 ? 2048 + g * 128 + (cl - 64) : 2560 + g * 128 + (cl - 192));
            CW[i] = (k < 4) ? a.in[I_SSDCW][k * NCV + ch] : a.in[I_SSDCB][ch]; }
        for (int i = tid; i < 17408 / 4; i += 512) ((LAS unsigned*)(lds + S_ST))[i] = 0u;
        f32x4 sacc[4];
#pragma unroll
        for (int pb = 0; pb < 4; ++pb) sacc[pb] = (f32x4){0.f, 0.f, 0.f, 0.f};
        __syncthreads();
#define SBAR() do { asm volatile("s_waitcnt lgkmcnt(0)" ::: "memory"); __builtin_amdgcn_s_barrier(); asm volatile("" ::: "memory"); } while (0)
        const int cgpB = tid & 15, rsB = tid >> 4, cgpX = tid & 7, rsX = tid >> 3;
        const bf16* BCb = (const bf16*)(a.ws + WS_H);
        u32x4 rC[4], rB[4], rX[5]; float dA = 0.f, dB = 0.f;
#define LOAD_RAW(cc) do { const int t0n = b * SEQ + (cc) * 128; \
            const bf16* sB = BCb + (size_t)(t0n + 4 * rsB) * D + g * 128 + 8 * cgpB; \
            const bf16* sX = XBC + (ptrdiff_t)(t0n + 2 * rsX - 3) * NCV + h * 64 + 8 * cgpX; \
            _Pragma("unroll") for (int i = 0; i < 4; ++i) { rB[i] = *(const u32x4*)(sB + (size_t)i * D); rC[i] = *(const u32x4*)(sB + (size_t)i * D + 512); } \
            _Pragma("unroll") for (int i = 0; i < 5; ++i) { const bool ok = ((cc) > 0) || (2 * rsX - 3 + i >= 0); rX[i] = ok ? *(const u32x4*)(sX + (ptrdiff_t)i * NCV) : (u32x4){0u, 0u, 0u, 0u}; } \
            if (wave < 2) { dA = DT[(size_t)(t0n + lane) * NH + h]; dB = DT[(size_t)(t0n + 64 + lane) * NH + h]; } } while (0)
        LOAD_RAW(0);
        for (int c = 0; c < 16; ++c) {
            const int t0 = b * SEQ + c * 128;
            if (wave < 2) {
                const float s0 = wave_scan_incl(dA * A_h, lane);
                if (wave == 0) { Acs[lane] = s0; dtv[lane] = dA; }
                else { const float tot0 = __shfl(s0, 63); const float s1 = wave_scan_incl(dB * A_h, lane); Acs[64 + lane] = s1 + tot0; dtv[64 + lane] = dB; }
            }
#pragma unroll
            for (int i = 0; i < 4; ++i) *(LAS u32x4*)(lds + S_CM + (4 * rsB + i) * RSB + cgpB * 16) = rC[i];
            SBAR();
            {
                const float alast = Acs[127]; const f32x4 as4 = *(const LAS f32x4*)(Acs + 4 * rsB);
                float E[4];
#pragma unroll
                for (int i = 0; i < 4; ++i) E[i] = fexp(alast - as4[i]);
#pragma unroll
                for (int j2 = 0; j2 < 4; ++j2) { float oa[4], ob[4];
#pragma unroll
                    for (int i = 0; i < 4; ++i) { oa[i] = bflo(rB[i][j2]); ob[i] = bfhi(rB[i][j2]); }
                    *(LAS u32x2*)(lds + S_BDT + (8 * cgpB + 2 * j2) * RSB + rsB * 8) = (u32x2){pk2(oa[0] * E[0], oa[1] * E[1]), pk2(oa[2] * E[2], oa[3] * E[3])};
                    *(LAS u32x2*)(lds + S_BDT + (8 * cgpB + 2 * j2 + 1) * RSB + rsB * 8) = (u32x2){pk2(ob[0] * E[0], ob[1] * E[1]), pk2(ob[2] * E[2], ob[3] * E[3])}; }
#pragma unroll
                for (int i = 0; i < 4; ++i) *(LAS u32x4*)(lds + S_BM + (4 * rsB + i) * RSB + cgpB * 16) = rB[i];
            }
            {
                const float d0 = dtv[2 * rsX], d1 = dtv[2 * rsX + 1];
#pragma unroll
                for (int j = 0; j < 8; ++j) { float o[2]; conv_col<2>(rX, j, CW + 8 * cgpX, o);
                    *(LAS unsigned*)(lds + S_XDT + (8 * cgpX + j) * RSB + rsX * 4) = pk2(o[0] * d0, o[1] * d1); }
            }
            if (c < 15) LOAD_RAW(c + 1);
            SBAR();
            bf16x8 Cf[4];
#pragma unroll
            for (int kk = 0; kk < 4; ++kk) Cf[kk] = *(const LAS bf16x8*)(lds + S_CM + (16 * wave + fr) * RSB + (32 * kk + 8 * fq) * 2);
            unsigned Mw[4][4];
#pragma unroll
            for (int kb = 0; kb < 4; ++kb)
#pragma unroll
                for (int e = 0; e < 4; ++e) Mw[kb][e] = 0u;
            const float acs_l = Acs[16 * wave + fr]; const int lidx = 16 * wave + fr;
#pragma unroll
            for (int sb = 0; sb < 8; ++sb) {
                if (sb <= wave) {
                    f32x4 s = {0.f, 0.f, 0.f, 0.f};
#pragma unroll
                    for (int kk = 0; kk < 4; ++kk) { const bf16x8 af = *(const LAS bf16x8*)(lds + S_BM + (16 * sb + fr) * RSB + (32 * kk + 8 * fq) * 2);
                        s = __builtin_amdgcn_mfma_f32_16x16x32_bf16(af, Cf[kk], s, 0, 0, 0); }
                    const f32x4 as4 = *(const LAS f32x4*)(Acs + 16 * sb + 4 * fq);
                    float v[4];
#pragma unroll
                    for (int i = 0; i < 4; ++i) { const int sidx = 16 * sb + 4 * fq + i; const float e = fexp(fminf(acs_l - as4[i], 0.f)); v[i] = (sidx <= lidx) ? s[i] * e : 0.f; }
                    Mw[sb >> 1][(sb & 1) * 2 + 0] = pk2(v[0], v[1]); Mw[sb >> 1][(sb & 1) * 2 + 1] = pk2(v[2], v[3]);
                }
            }
            f32x4 yd[4];
#pragma unroll
            for (int pb = 0; pb < 4; ++pb) yd[pb] = (f32x4){0.f, 0.f, 0.f, 0.f};
            if (c > 0) {
#pragma unroll
                for (int kk = 0; kk < 4; ++kk)
#pragma unroll
                    for (int pb = 0; pb < 4; ++pb) { const bf16x8 sf = *(const LAS bf16x8*)(lds + S_ST + (16 * pb + fr) * RSB + (32 * kk + 8 * fq) * 2);
                        yd[pb] = __builtin_amdgcn_mfma_f32_16x16x32_bf16(Cf[kk], sf, yd[pb], 0, 0, 0); }
                const f32x4 al4 = *(const LAS f32x4*)(Acs + 16 * wave + 4 * fq);
                f32x4 ea4;
#pragma unroll
                for (int i = 0; i < 4; ++i) ea4[i] = fexp(al4[i]);
#pragma unroll
                for (int pb = 0; pb < 4; ++pb) yd[pb] = yd[pb] * ea4;
            }
            bf16 zr[4][4];
#pragma unroll
            for (int pb = 0; pb < 4; ++pb)
#pragma unroll
                for (int i = 0; i < 4; ++i) zr[pb][i] = Z[(size_t)(t0 + 16 * wave + 4 * fq + i) * DIN + h * 64 + 16 * pb + fr];
#pragma unroll
            for (int kb = 0; kb < 4; ++kb) {
                if (2 * kb <= wave) {
                    const u32x4 mw = {Mw[kb][0], Mw[kb][1], Mw[kb][2], Mw[kb][3]}; const bf16x8 mf = __builtin_bit_cast(bf16x8, mw);
#pragma unroll
                    for (int pb = 0; pb < 4; ++pb) { const u32x2 lo = *(const LAS u32x2*)(lds + S_XDT + (16 * pb + fr) * RSB + (32 * kb + 4 * fq) * 2);
                        const u32x2 hi = *(const LAS u32x2*)(lds + S_XDT + (16 * pb + fr) * RSB + (32 * kb + 16 + 4 * fq) * 2);
                        const u32x4 xw = {lo.x, lo.y, hi.x, hi.y};
                        yd[pb] = __builtin_amdgcn_mfma_f32_16x16x32_bf16(mf, __builtin_bit_cast(bf16x8, xw), yd[pb], 0, 0, 0); }
                }
            }
            {
                const f32x4 dt4 = *(const LAS f32x4*)(dtv + 16 * wave + 4 * fq);
                float rdt[4], ssq[4];
#pragma unroll
                for (int i = 0; i < 4; ++i) { rdt[i] = __builtin_amdgcn_rcpf(dt4[i]); ssq[i] = 0.f; }
#pragma unroll
                for (int pb = 0; pb < 4; ++pb) {
                    const u32x2 xd = *(const LAS u32x2*)(lds + S_XDT + (16 * pb + fr) * RSB + (16 * wave + 4 * fq) * 2);
                    const float xv[4] = {bflo(xd.x), bfhi(xd.x), bflo(xd.y), bfhi(xd.y)};
#pragma unroll
                    for (int i = 0; i < 4; ++i) {
                        const float z = bf1(zr[pb][i]);
                        const float y = yd[pb][i] + D_h * xv[i] * rdt[i];
                        const float yz = y * silu_f(z);
                        Z[(size_t)(t0 + 16 * wave + 4 * fq + i) * DIN + h * 64 + 16 * pb + fr] = (bf16)(pk2(yz, 0.f) & 0xffffu); ssq[i] += yz * yz;
                    }
                }
#pragma unroll
                for (int i = 0; i < 4; ++i) { float s = ssq[i]; s += __shfl_xor(s, 1); s += __shfl_xor(s, 2); s += __shfl_xor(s, 4); s += __shfl_xor(s, 8);
                    if (fr == 0) SS[(size_t)(t0 + 16 * wave + 4 * fq + i) * NH + h] = s; }
            }
            if (c < 15) {
                const float dec = fexp(Acs[127]);
#pragma unroll
                for (int pb = 0; pb < 4; ++pb) sacc[pb] = sacc[pb] * dec;
#pragma unroll
                for (int ks = 0; ks < 4; ++ks) { const bf16x8 bfr = *(const LAS bf16x8*)(lds + S_BDT + (16 * wave + fr) * RSB + (32 * ks + 8 * fq) * 2);
#pragma unroll
                    for (int pb = 0; pb < 4; ++pb) { const bf16x8 xf = *(const LAS bf16x8*)(lds + S_XDT + (16 * pb + fr) * RSB + (32 * ks + 8 * fq) * 2);
                        sacc[pb] = __builtin_amdgcn_mfma_f32_16x16x32_bf16(bfr, xf, sacc[pb], 0, 0, 0); } }
            }
            SBAR();
            if (c < 15) {
#pragma unroll
                for (int pb = 0; pb < 4; ++pb) *(LAS u32x2*)(lds + S_ST + (16 * pb + fr) * RSB + (16 * wave + 4 * fq) * 2) = (u32x2){pk2(sacc[pb][0], sacc[pb][1]), pk2(sacc[pb][2], sacc[pb][3])};
            }
        }
#undef LOAD_RAW
        asm volatile("s_waitcnt vmcnt(0) lgkmcnt(0)" ::: "memory");
    }
}

__device__ __forceinline__ void gnorm_phase(const Args& a, int bid, int G, int lane, int wave) {
    bf16* YZ = (bf16*)(a.ws + WS_Z); const float* SS = (const float*)(a.ws + WS_SS); const float* nw = a.in[I_SSDNW];
    for (int row = bid * 8 + wave; row < M; row += G * 8) {
#pragma unroll
        for (int g = 0; g < 4; ++g) {
            u32x4* p = (u32x4*)(YZ + (size_t)row * DIN + g * 512 + lane * 8);
            const u32x4 v = *p;
            float s = SS[(size_t)row * NH + g * 8 + (lane & 7)]; s += __shfl_xor(s, 1); s += __shfl_xor(s, 2); s += __shfl_xor(s, 4);
            const float rs = __builtin_amdgcn_rsqf(s * (1.0f / 512.0f) + EPS);
            const f32x4 w0 = *(const f32x4*)(nw + g * 512 + lane * 8), w1 = *(const f32x4*)(nw + g * 512 + lane * 8 + 4);
            u32x4 o; o.x = pk2(bflo(v.x) * rs * w0.x, bfhi(v.x) * rs * w0.y); o.y = pk2(bflo(v.y) * rs * w0.z, bfhi(v.y) * rs * w0.w);
            o.z = pk2(bflo(v.z) * rs * w1.x, bfhi(v.z) * rs * w1.y); o.w = pk2(bflo(v.w) * rs * w1.z, bfhi(v.w) * rs * w1.w);
            *p = o;
        }
    }
}

__device__ __forceinline__ void sconv_phase(const Args& a, int bid, int G, int lane, int wave) {
    const bf16* P = (const bf16*)(a.ws + WS_PROJ); bf16* Y = (bf16*)(a.ws + WS_YSC); const float* cw = a.in[I_SCCW];
    for (int it = bid * 8 + wave; it < 2048; it += G * 8) {
        const int seg = it >> 1, col = (it & 1) * 512 + lane * 8, row0 = seg * 16;
        float w[3][8];
#pragma unroll
        for (int k = 0; k < 3; ++k) { const f32x4 a0 = *(const f32x4*)(cw + k * D + col), a1 = *(const f32x4*)(cw + k * D + col + 4);
            w[k][0] = a0.x; w[k][1] = a0.y; w[k][2] = a0.z; w[k][3] = a0.w; w[k][4] = a1.x; w[k][5] = a1.y; w[k][6] = a1.z; w[k][7] = a1.w; }
        float u2[8], u1[8];
#pragma unroll
        for (int j = 0; j < 8; ++j) { u2[j] = 0.f; u1[j] = 0.f; }
        if ((row0 & (SEQ - 1)) != 0) {
            const u32x4 c2 = *(const u32x4*)(P + (size_t)(row0 - 2) * NCV + D + col), x2 = *(const u32x4*)(P + (size_t)(row0 - 2) * NCV + 2 * D + col);
            const u32x4 c1 = *(const u32x4*)(P + (size_t)(row0 - 1) * NCV + D + col), x1 = *(const u32x4*)(P + (size_t)(row0 - 1) * NCV + 2 * D + col);
#pragma unroll
            for (int q = 0; q < 4; ++q) { u2[2 * q] = bflo(c2[q]) * bflo(x2[q]); u2[2 * q + 1] = bfhi(c2[q]) * bfhi(x2[q]); u1[2 * q] = bflo(c1[q]) * bflo(x1[q]); u1[2 * q + 1] = bfhi(c1[q]) * bfhi(x1[q]); }
        }
#pragma unroll 4
        for (int r = 0; r < 16; ++r) {
            const bf16* rp = P + (size_t)(row0 + r) * NCV + col;
            const u32x4 bg = *(const u32x4*)rp, cv = *(const u32x4*)(rp + D), xv = *(const u32x4*)(rp + 2 * D);
            float u0[8], y[8];
#pragma unroll
            for (int q = 0; q < 4; ++q) { u0[2 * q] = bflo(cv[q]) * bflo(xv[q]); u0[2 * q + 1] = bfhi(cv[q]) * bfhi(xv[q]); }
#pragma unroll
            for (int j = 0; j < 8; ++j) { const float bgv = (j & 1) ? bfhi(bg[j >> 1]) : bflo(bg[j >> 1]); y[j] = bgv * (w[0][j] * u2[j] + w[1][j] * u1[j] + w[2][j] * u0[j]); u2[j] = u1[j]; u1[j] = u0[j]; }
            *(u32x4*)(Y + (size_t)(row0 + r) * D + col) = (u32x4){pk2(y[0], y[1]), pk2(y[2], y[3]), pk2(y[4], y[5]), pk2(y[6], y[7])};
        }
    }
}

__device__ __forceinline__ void fnorm_phase(const Args& a, int bid, int G, int lane, int wave) {
    const float* gw = a.in[I_FNW];
    for (int row = bid * 8 + wave; row < M; row += G * 8) {
        f32x4* xr = (f32x4*)(a.out + (size_t)row * D) + lane;
        f32x4 v[4]; float s = 0.f;
#pragma unroll
        for (int j = 0; j < 4; ++j) { v[j] = xr[64 * j]; s += (v[j].x * v[j].x + v[j].y * v[j].y) + (v[j].z * v[j].z + v[j].w * v[j].w); }
        const float rstd = __builtin_amdgcn_rsqf(wave_sum(s) * (1.f / D) + EPS);
#pragma unroll
        for (int j = 0; j < 4; ++j) { const f32x4 w = *(const f32x4*)(gw + 4 * lane + 256 * j); xr[64 * j] = v[j] * rstd * w; }
    }
}


#define XB_TMO      128
#define XB_XCNT(j)  (256  + 64 * (j))
#define XB_XSUB(j)  (1280 + 64 * (j))
#define XB_XGEN(j)  (2304 + 64 * (j))
#define XB_TOP      3328
#define XB_TOPGEN   3392
#define XCD_BAR_WORDS 3456
#define XB_SPIN_CAP (1u << 18)

__device__ __forceinline__ unsigned xb_ld(unsigned* p)              { return __hip_atomic_load(p, __ATOMIC_RELAXED, __HIP_MEMORY_SCOPE_AGENT); }
__device__ __forceinline__ unsigned xb_add(unsigned* p, unsigned v) { return __hip_atomic_fetch_add(p, v, __ATOMIC_RELAXED, __HIP_MEMORY_SCOPE_AGENT); }
__device__ __forceinline__ unsigned xb_xcc_id() { return (unsigned)__builtin_amdgcn_s_getreg((3 << 11) | 20) & 0xFu; }
#define XB_SPIN(cond, bar) do { unsigned _sp = 0; while (cond) { __builtin_amdgcn_s_sleep(1); \
    if ((++_sp & 255u) == 0u) { if (xb_ld(&(bar)[XB_TMO])) break; if (_sp > XB_SPIN_CAP) { atomicAdd(&(bar)[XB_TMO], 1u); break; } } } } while (0)

struct XcdBarrier {
    unsigned* bar; unsigned x;
    volatile LAS unsigned* st;
};

__device__ __forceinline__ XcdBarrier xcd_barrier_post(unsigned* bar, volatile LAS unsigned* st) {
    XcdBarrier b; b.bar = bar; b.x = xb_xcc_id(); b.st = st;
    if (threadIdx.x == 0) (void)xb_add(&bar[XB_XCNT(b.x)], 1u);
    return b;
}
__device__ __forceinline__ void xcd_barrier_complete(unsigned* bar, unsigned x, unsigned& nloc, unsigned& nx) {
    const unsigned G = gridDim.x * gridDim.y * gridDim.z;
    unsigned sum, cnt, mine, sp = 0u;
    for (;;) {
        sum = 0u; cnt = 0u; mine = 0u;
#pragma unroll
        for (unsigned j = 0; j < 16; ++j) { const unsigned c = xb_ld(&bar[XB_XCNT(j)]); sum += c; cnt += (c > 0u) ? 1u : 0u; mine = (j == x) ? c : mine; }
        if (sum == G) break;
        __builtin_amdgcn_s_sleep(1);
        if ((++sp & 255u) == 0u) { if (xb_ld(&bar[XB_TMO])) break; if (sp > XB_SPIN_CAP) { atomicAdd(&bar[XB_TMO], 1u); break; } }
    }
    nloc = mine > 0u ? mine : 1u; nx = cnt > 0u ? cnt : 1u;
}

__device__ __forceinline__ void xcd_barrier(const XcdBarrier& b) {
    asm volatile("s_waitcnt vmcnt(0)" ::: "memory");
    __syncthreads();
    if (threadIdx.x == 0) {
        unsigned* bar = b.bar;
        __builtin_amdgcn_s_waitcnt(0);
        unsigned nloc = b.st[0], nx = b.st[1];
        if (nloc == 0u) { xcd_barrier_complete(bar, b.x, nloc, nx); b.st[0] = nloc; b.st[1] = nx; }
        const unsigned old = xb_add(&bar[XB_XSUB(b.x)], 1u);
        const unsigned gen = old / nloc;
        if (old + 1u == (gen + 1u) * nloc) {
            __builtin_amdgcn_fence(__ATOMIC_RELEASE, "agent");
            asm volatile("s_waitcnt vmcnt(0)" ::: "memory");
            const unsigned og = xb_add(&bar[XB_TOP], 1u);
            const unsigned tg = og / nx;
            if (og + 1u == (tg + 1u) * nx) xb_add(&bar[XB_TOPGEN], 1u);
            else XB_SPIN(xb_ld(&bar[XB_TOPGEN]) == tg, bar);
            __builtin_amdgcn_fence(__ATOMIC_ACQUIRE, "agent");
            xb_add(&bar[XB_XGEN(b.x)], 1u);
            asm volatile("s_waitcnt vmcnt(0)" ::: "memory");
        } else {
            XB_SPIN(xb_ld(&bar[XB_XGEN(b.x)]) == gen, bar);
            __builtin_amdgcn_fence(__ATOMIC_ACQUIRE, "agent");
            asm volatile("s_waitcnt vmcnt(0)" ::: "memory");
        }
    }
    __syncthreads();
}

#ifndef AMP_MASK
#define AMP_MASK 0
#endif
#ifndef AMP_K
#define AMP_K 1
#endif
#ifndef SYNC_REP
#define SYNC_REP 1
#endif
#define PH(id, ...) do { if ((AMP_MASK >> (id)) & 1) { const unsigned long long _t0 = __builtin_amdgcn_s_memrealtime(); __VA_ARGS__; __syncthreads(); \
    const unsigned long long _el = __builtin_amdgcn_s_memrealtime() - _t0; while (__builtin_amdgcn_s_memrealtime() - _t0 < _el * (1 + AMP_K)) __builtin_amdgcn_s_sleep(8); } else { __VA_ARGS__; } } while (0)
__device__ __forceinline__ void gsync_cg(cg::grid_group& grid) {
    asm volatile("s_waitcnt vmcnt(0) lgkmcnt(0)" ::: "memory");
    __threadfence();
    grid.sync();
    __threadfence();
}
#define gsync(grid) xcd_barrier(xbar)
template <class Epi>
__device__ __forceinline__ void run_gemm(LAS unsigned char* lds, const bf16* A, const bf16* Bt, int N, int K, const Epi& E, int G, int bid) {
    pg8::Gemm g{A, Bt, M, N, K}; pg8::StaticOrder S; S.init(M, N, G, bid);
    pg8::gemm_phase<Epi, pg8::StaticOrder, true, true>(lds, g, S, E);
}

__global__ void __launch_bounds__(512, 2) mk_fwd(Args a) {
    extern __shared__ __attribute__((aligned(16))) unsigned char lds_raw[];
    LAS unsigned char* lds = (LAS unsigned char*)lds_raw;
    cg::grid_group grid = cg::this_grid();
    const int tid = threadIdx.x, lane = tid & 63, wave = __builtin_amdgcn_readfirstlane(tid >> 6), bid = blockIdx.x, G = gridDim.x;
    unsigned char* ws = a.ws;
    bf16* H = (bf16*)(ws + WS_H);
    const float* MOD = (const float*)(ws + WS_MOD);

    if (bid == 0) for (int i = tid; i < XCD_BAR_WORDS; i += 512) ((unsigned*)ws)[i] = 0u;
    if (tid < 16) ((volatile LAS unsigned*)(lds + LDS_BYTES - 64))[tid] = 0u;
    asm volatile("s_waitcnt vmcnt(0) lgkmcnt(0)" ::: "memory");
    grid.sync();
    XcdBarrier xbar = xcd_barrier_post((unsigned*)ws, (volatile LAS unsigned*)(lds + LDS_BYTES - 64));
    PH(0, p0_phase(a, lds, bid, G, tid, lane, wave));
    gsync(grid);
    mod_finalize(a, bid, G, tid);
    PH(1, norm_phase<true>(a, lds, a.in[I_X], a.in[I_MIXNW], 0, 0, 1024, H, bid, G, tid, lane, wave));
    gsync(grid);
    { pg8::EpiBf16S<0> E{(bf16*)(ws + WS_Z), DIN, (bf16*)(ws + WS_XBC), NCV, DIN};
      PH(2, run_gemm(lds, H, (const bf16*)(ws + WS_WIN), 5120, D, E, G, bid)); }
    PH(4, dt_phase(a, bid, G, lane, wave));
    gsync(grid);
    PH(1, bcconv_phase(a, bid, G, lane, wave));
    gsync(grid);
    PH(3, ssd_phase(a, lds, bid, G, tid, lane, wave));
    gsync(grid);
    PH(1, gnorm_phase(a, bid, G, lane, wave));
    gsync(grid);
    { pg8::EpiRes E{a.in[I_X], a.out, MOD + 2048};
      PH(2, run_gemm(lds, (const bf16*)(ws + WS_Z), (const bf16*)(ws + WS_WOUT), D, DIN, E, G, bid)); }
    gsync(grid);
    PH(1, norm_phase<false>(a, lds, a.out, a.in[I_MLPNW], 0, 3072, 4096, H, bid, G, tid, lane, wave));
    gsync(grid);
    { pg8::EpiBf16S<2> E{(bf16*)(ws + WS_ACT), DFF, (bf16*)(ws + WS_ACT), DFF, 1 << 30};
      PH(2, run_gemm(lds, H, (const bf16*)(ws + WS_WUP0), DFF, D, E, G, bid)); }
    gsync(grid);
    { pg8::EpiRes E{a.out, a.out, MOD + 5120};
      PH(2, run_gemm(lds, (const bf16*)(ws + WS_ACT), (const bf16*)(ws + WS_WDN0), D, DFF, E, G, bid)); }
    gsync(grid);
    PH(1, norm_phase<false>(a, lds, a.out, a.in[I_MIXNW] + D, 1, 0, 1024, H, bid, G, tid, lane, wave));
    gsync(grid);
    { pg8::EpiBf16S<0> E{(bf16*)(ws + WS_PROJ), NCV, (bf16*)(ws + WS_PROJ), NCV, 1 << 30};
      PH(2, run_gemm(lds, H, (const bf16*)(ws + WS_WSCIN), NCV, D, E, G, bid)); }
    gsync(grid);
    PH(1, sconv_phase(a, bid, G, lane, wave));
    gsync(grid);
    { pg8::EpiRes E{a.out, a.out, MOD + 8 * MODW + 2048};
      PH(2, run_gemm(lds, (const bf16*)(ws + WS_YSC), (const bf16*)(ws + WS_WSCOUT), D, D, E, G, bid)); }
    gsync(grid);
    PH(1, norm_phase<false>(a, lds, a.out, a.in[I_MLPNW] + D, 1, 3072, 4096, H, bid, G, tid, lane, wave));
    gsync(grid);
    { pg8::EpiBf16S<2> E{(bf16*)(ws + WS_ACT), DFF, (bf16*)(ws + WS_ACT), DFF, 1 << 30};
      PH(2, run_gemm(lds, H, (const bf16*)(ws + WS_WUP1), DFF, D, E, G, bid)); }
    gsync(grid);
    { pg8::EpiRes E{a.out, a.out, MOD + 8 * MODW + 5120};
      PH(2, run_gemm(lds, (const bf16*)(ws + WS_ACT), (const bf16*)(ws + WS_WDN1), D, DFF, E, G, bid)); }
    gsync(grid);
    PH(1, fnorm_phase(a, bid, G, lane, wave));
}

extern "C" void kernel_launch(void* const* d_in, const int* in_sizes, int n_in, void* d_out, int out_size, void* d_ws, size_t ws_size, hipStream_t stream) {
    static int grid = 0;
    if (grid == 0) {
        if (n_in != 20 || in_sizes[0] != M * D || out_size != M * D || ws_size < WS_END) { fprintf(stderr, "kernel_launch: unexpected shapes (n_in %d, in0 %d, out %d, ws %zu)\n", n_in, n_in > 0 ? in_sizes[0] : -1, out_size, ws_size); grid = -1; return; }
        int dev = 0, cus = 0, per_cu = 0;
        hipGetDevice(&dev); hipDeviceGetAttribute(&cus, hipDeviceAttributeMultiprocessorCount, dev);
        if (hipFuncSetAttribute((const void*)mk_fwd, hipFuncAttributeMaxDynamicSharedMemorySize, LDS_BYTES) != hipSuccess) { fprintf(stderr, "kernel_launch: hipFuncSetAttribute failed\n"); grid = -1; return; }
        if (hipOccupancyMaxActiveBlocksPerMultiprocessor(&per_cu, (const void*)mk_fwd, 512, LDS_BYTES) != hipSuccess || per_cu < 1) { fprintf(stderr, "kernel_launch: occupancy query says %d blocks per CU\n", per_cu); (void)hipGetLastError(); per_cu = 1; }
        grid = cus;
        if (grid <= 0) { grid = -1; return; }
    }
    if (grid < 0) return;
    Args a{};
    for (int i = 0; i < 20; ++i) a.in[i] = (const float*)d_in[i];
    a.out = (float*)d_out; a.ws = (unsigned char*)d_ws;
    void* args[] = {&a};
    hipError_t e = hipLaunchCooperativeKernel((const void*)mk_fwd, dim3(grid), dim3(512), args, LDS_BYTES, stream);
    if (e != hipSuccess) fprintf(stderr, "cooperative launch failed: %s (grid %d)\n", hipGetErrorString(e), grid);
}
```

```cpp
#include <hip/hip_runtime.h>
#include <hip/hip_cooperative_groups.h>
#include <cstdio>
#include <cstdint>
namespace cg = cooperative_groups;
namespace pg8 {
#define PG8_LAS __attribute__((address_space(3)))
typedef unsigned short bf16_t;
typedef short bf16x8 __attribute__((ext_vector_type(8)));
typedef float f32x4 __attribute__((ext_vector_type(4)));
typedef unsigned u32x4 __attribute__((ext_vector_type(4)));
typedef unsigned u32x2 __attribute__((ext_vector_type(2)));
constexpr int BM = 256, BK = 64, HALF = 128, HTB = HALF * BK * 2  , STAGE_BYTES = 8 * HTB, NXCD = 8, WGM = 8;

__host__ __device__ __forceinline__ int lds_byte(int r, int c) { const int st = (r >> 4) * 2 + (c >> 5), rr = r & 15, cc = c & 31, ob = rr * 64 + cc * 2; return st * 1024 + (ob ^ (((ob >> 9) & 1) << 5)); }
__host__ __device__ __forceinline__ void stage_rc(int b, int& R, int& C) { const int st = b / 1024, sb = b % 1024, swz = sb ^ (((sb >> 9) & 1) << 5); R = (st >> 1) * 16 + swz / 64; C = (st & 1) * 32 + (swz % 64) / 2; }
__host__ __device__ __forceinline__ int perm32(int rho) { const int n = rho >> 4, i = rho & 15; return 8 * (i >> 2) + 4 * n + (i & 3); }

struct Unit { int pm, pn; };
struct Gemm { const bf16_t* A; const bf16_t* Bt; int M, N, K; };

struct StaticOrder {
    int nM, nN, nwg, G, c;
    __host__ __device__ void init(int M, int N, int G_, int c_) { nM = M / BM; nN = N / BM; nwg = nM * nN; G = G_; c = c_; }
    __host__ __device__ bool next(int i, Unit& u) const {
        const long L = (long)i * G + c; if (L >= nwg) return false;
        int wgid = (int)L; { const int q = nwg / NXCD, r = nwg % NXCD, xcd = wgid % NXCD, off = wgid / NXCD; wgid = (xcd < r ? xcd * (q + 1) : r * (q + 1) + (xcd - r) * q) + off; }
        const int nig = WGM * nN, gid = wgid / nig, fm = gid * WGM, gsz = (nM - fm) < WGM ? (nM - fm) : WGM;
        u.pm = fm + ((wgid % nig) % gsz); u.pn = (wgid % nig) / gsz; return true;
    }
    __device__ __forceinline__ void a_ready(const Unit&) const {}
    __device__ __forceinline__ void done(const Unit&) const {}
};
__device__ __forceinline__ unsigned cvt_pk_bf16(float lo, float hi) { unsigned r; asm volatile("v_cvt_pk_bf16_f32 %0, %1, %2" : "=v"(r) : "v"(lo), "v"(hi)); return r; }
typedef float f32x2 __attribute__((ext_vector_type(2)));
__device__ __forceinline__ unsigned pk2bf(float lo, float hi) { unsigned r; asm("v_cvt_pk_bf16_f32 %0, %1, %2" : "=v"(r) : "v"(lo), "v"(hi)); return r; }
template <int ACT  > struct EpiBf16S {
    static constexpr bool PERM = true, AFTER_DRAIN = false;
    bf16_t* O0; int ld0; bf16_t* O1; int ld1; int csplit;
    __device__ __forceinline__ void operator()(const f32x4 (&acc)[2][2][4][2], const Unit& u, int wr, int wc, int fr, int fq) const {
        const int row0 = u.pm * BM + wr * 64 + fr; int colt = u.pn * BM; bf16_t* base = O0; int ldc = ld0;
        if (colt >= csplit) { base = O1; ldc = ld1; colt -= csplit; }
        const int col0 = colt + wc * 32 + 8 * fq;
#pragma unroll
        for (int ai = 0; ai < 2; ++ai)
#pragma unroll
            for (int m = 0; m < 4; ++m) { bf16_t* rowp = base + (size_t)(row0 + ai * HALF + m * 16) * ldc + col0;
#pragma unroll
                for (int bj = 0; bj < 2; ++bj) { f32x4 v0 = acc[ai][bj][m][0], v1 = acc[ai][bj][m][1];
                    if (ACT == 2) {
#pragma unroll
                        for (int e = 0; e < 4; ++e) { float a0 = fmaxf(v0[e], 0.f), a1 = fmaxf(v1[e], 0.f); v0[e] = a0 * a0; v1[e] = a1 * a1; } }
                    u32x4 w; w.x = pk2bf(v0[0], v0[1]); w.y = pk2bf(v0[2], v0[3]); w.z = pk2bf(v1[0], v1[1]); w.w = pk2bf(v1[2], v1[3]);
                    *(u32x4*)(rowp + bj * HALF) = w; } }
    }
};
struct EpiRes {
    static constexpr bool PERM = true, AFTER_DRAIN = false;
    const float* base; float* out; const float* gate;
    __device__ __forceinline__ void operator()(const f32x4 (&acc)[2][2][4][2], const Unit& u, int wr, int wc, int fr, int fq) const {
        const int b = (u.pm * BM) >> 11; const float* gp = gate + (size_t)b * 6144;
        const int col0 = u.pn * BM + wc * 32 + 8 * fq;
        f32x4 gv[2][2];
#pragma unroll
        for (int bj = 0; bj < 2; ++bj)
#pragma unroll
            for (int n = 0; n < 2; ++n) gv[bj][n] = *(const f32x4*)(gp + col0 + bj * HALF + n * 4);
#pragma unroll
        for (int ai = 0; ai < 2; ++ai)
#pragma unroll
            for (int m = 0; m < 4; ++m) { const size_t off = (size_t)(u.pm * BM + ai * HALF + wr * 64 + m * 16 + fr) * 1024 + col0;
#pragma unroll
                for (int bj = 0; bj < 2; ++bj)
#pragma unroll
                    for (int n = 0; n < 2; ++n) { const f32x4 bs = *(const f32x4*)(base + off + bj * HALF + n * 4);
                        *(f32x4*)(out + off + bj * HALF + n * 4) = bs + gv[bj][n] * acc[ai][bj][m][n]; }
                asm volatile("" ::: "memory"); }
    }
};
struct EpiRes2 {
    static constexpr bool PERM = true, AFTER_DRAIN = false;
    const float* base; float* out; const float* gate; bf16_t* xa; const float* nw; const float* sc; float* ssq;
    __device__ __forceinline__ void operator()(const f32x4 (&acc)[2][2][4][2], const Unit& u, int wr, int wc, int fr, int fq) const {
        const int b = (u.pm * BM) >> 11; const float* gp = gate + (size_t)b * 6144; const float* sp = sc + (size_t)b * 6144;
        const int col0 = u.pn * BM + wc * 32 + 8 * fq;
        f32x4 gv[2][2], av[2][2];
#pragma unroll
        for (int bj = 0; bj < 2; ++bj)
#pragma unroll
            for (int n = 0; n < 2; ++n) { const int c = col0 + bj * HALF + n * 4; gv[bj][n] = *(const f32x4*)(gp + c); av[bj][n] = *(const f32x4*)(nw + c) * (1.0f + *(const f32x4*)(sp + c)); }
#pragma unroll
        for (int ai = 0; ai < 2; ++ai)
#pragma unroll
            for (int m = 0; m < 4; ++m) { const int row = u.pm * BM + ai * HALF + wr * 64 + m * 16 + fr; const size_t off = (size_t)row * 1024 + col0; float s = 0.f;
#pragma unroll
                for (int bj = 0; bj < 2; ++bj) { u32x4 w;
#pragma unroll
                    for (int n = 0; n < 2; ++n) { const f32x4 bs = *(const f32x4*)(base + off + bj * HALF + n * 4);
                        const f32x4 o = bs + gv[bj][n] * acc[ai][bj][m][n];
                        *(f32x4*)(out + off + bj * HALF + n * 4) = o; s += (o[0] * o[0] + o[1] * o[1]) + (o[2] * o[2] + o[3] * o[3]);
                        const f32x4 xv = o * av[bj][n]; w[2 * n] = pk2bf(xv[0], xv[1]); w[2 * n + 1] = pk2bf(xv[2], xv[3]); }
                    *(u32x4*)(xa + off + bj * HALF) = w; }
                s += __shfl_xor(s, 16); s += __shfl_xor(s, 32);
                if (fq == 0) ssq[(size_t)row * 16 + u.pn * 4 + wc] = s;
                asm volatile("" ::: "memory"); }
    }
};
template <int ACT  > struct EpiBf16N {
    static constexpr bool PERM = true, AFTER_DRAIN = false;
    bf16_t* O; int ldc; const float* sw; const float* ssq;
    __device__ __forceinline__ void operator()(const f32x4 (&acc)[2][2][4][2], const Unit& u, int wr, int wc, int fr, int fq) const {
        const int row0 = u.pm * BM + wr * 64 + fr, b = (u.pm * BM) >> 11, col0 = u.pn * BM + wc * 32 + 8 * fq;
        f32x4 sv[2][2];
#pragma unroll
        for (int bj = 0; bj < 2; ++bj)
#pragma unroll
            for (int n = 0; n < 2; ++n) sv[bj][n] = *(const f32x4*)(sw + (size_t)b * 4096 + col0 + bj * HALF + 4 * n);
#pragma unroll
        for (int ai = 0; ai < 2; ++ai)
#pragma unroll
            for (int m = 0; m < 4; ++m) { const int row = row0 + ai * HALF + m * 16; bf16_t* rowp = O + (size_t)row * ldc + col0;
                const f32x4 q = *(const f32x4*)(ssq + (size_t)row * 16 + 4 * fq); float s = (q[0] + q[1]) + (q[2] + q[3]); s += __shfl_xor(s, 16); s += __shfl_xor(s, 32);
                const float rstd = __builtin_amdgcn_rsqf(s * (1.0f / 1024.0f) + 1e-5f);
#pragma unroll
                for (int bj = 0; bj < 2; ++bj) { f32x4 v0 = acc[ai][bj][m][0] * rstd + sv[bj][0], v1 = acc[ai][bj][m][1] * rstd + sv[bj][1];
                    if (ACT == 2) {
#pragma unroll
                        for (int e = 0; e < 4; ++e) { float a0 = fmaxf(v0[e], 0.f), a1 = fmaxf(v1[e], 0.f); v0[e] = a0 * a0; v1[e] = a1 * a1; } }
                    u32x4 w; w.x = pk2bf(v0[0], v0[1]); w.y = pk2bf(v0[2], v0[3]); w.z = pk2bf(v1[0], v1[1]); w.w = pk2bf(v1[2], v1[3]);
                    *(u32x4*)(rowp + bj * HALF) = w; } }
    }
};

template <class Epi, class Sched, bool ALIGN_EPI = false, bool SP2 = false>
__device__ __forceinline__ void gemm_phase(PG8_LAS unsigned char* lds, const Gemm g, const Sched& S, const Epi& E) {
    int tid_ = threadIdx.x; asm volatile("" : "+v"(tid_));
    const int tid = tid_, wid = __builtin_amdgcn_readfirstlane(tid >> 6), lane = tid & 63, wr = wid >> 2, wc = wid & 3, fr = lane & 15, fq = lane >> 4;
    const int K = g.K, nt = K / BK;
    unsigned voffA[2], voffB[2];
#pragma unroll
    for (int i = 0; i < 2; ++i) { int R, C; stage_rc(tid * 16 + i * 8192, R, C); const int Rb = Epi::PERM ? ((R & ~31) + perm32(R & 31)) : R;
        voffA[i] = (unsigned)(R * K + C) * 2u; voffB[i] = (unsigned)(Rb * K + C) * 2u; }
    const size_t kstep = (size_t)(BK * 2);
    const size_t hstep = (size_t)HALF * K * 2;
    const size_t tstep = 2 * hstep;
    const unsigned ldsw = (unsigned)wid * 1024u;
    const int aoff = lds_byte(wr * 64 + fr, fq * 8), boff = lds_byte(wc * 32 + fr, fq * 8);
#define PG8_SA(b, h) (((b) * 2 + (h)) * HTB)
#define PG8_SB(b, h) ((4 + (b) * 2 + (h)) * HTB)
#define PG8_STAGE(bufoff, gbase, voff) do { _Pragma("unroll") for (int _i = 0; _i < 2; ++_i) \
        __builtin_amdgcn_global_load_lds((const unsigned*)((const char*)(gbase) + (voff)[_i]), (PG8_LAS unsigned*)(lds + (bufoff) + ldsw + _i * 8192), 16, 0, 0); } while (0)
#define PG8_LDA(dst, b, h) do { _Pragma("unroll") for (int m = 0; m < 4; ++m) _Pragma("unroll") for (int k = 0; k < 2; ++k) dst[m][k] = *(const PG8_LAS bf16x8*)(lds + PG8_SA(b, h) + aoff + m * 2048 + k * 1024); } while (0)
#define PG8_LDB(dst, b, h) do { _Pragma("unroll") for (int n = 0; n < 2; ++n) _Pragma("unroll") for (int k = 0; k < 2; ++k) dst[n][k] = *(const PG8_LAS bf16x8*)(lds + PG8_SB(b, h) + boff + n * 2048 + k * 1024); } while (0)
#define PG8_MMA(ai, bj, At, Bt) do { __builtin_amdgcn_s_setprio(1); _Pragma("unroll") for (int m = 0; m < 4; ++m) _Pragma("unroll") for (int n = 0; n < 2; ++n) _Pragma("unroll") for (int k = 0; k < 2; ++k) \
        acc[ai][bj][m][n] = __builtin_amdgcn_mfma_f32_16x16x32_bf16(Bt[n][k], At[m][k], acc[ai][bj][m][n], 0, 0, 0); __builtin_amdgcn_s_setprio(0); } while (0)
#define PG8_WAIT_V(n) asm volatile("s_waitcnt vmcnt(" #n ")" ::: "memory")
#define PG8_WAIT_L(n) asm volatile("s_waitcnt lgkmcnt(" #n ")" ::: "memory")
#define PG8_BAR __builtin_amdgcn_s_barrier()
#define PG8_SCHED __builtin_amdgcn_sched_barrier(0)
    Unit cur, nxt; int ui = 0;
    if (!S.next(0, cur)) return;
    f32x4 acc[2][2][4][2];
#pragma unroll
    for (int a = 0; a < 2; ++a)
#pragma unroll
        for (int b = 0; b < 2; ++b)
#pragma unroll
            for (int m = 0; m < 4; ++m)
#pragma unroll
                for (int n = 0; n < 2; ++n) acc[a][b][m][n] = (f32x4){0.f, 0.f, 0.f, 0.f};
    bf16x8 At[4][2], B0[2][2], B1[2][2];
    const char* cA = (const char*)g.A + (size_t)cur.pm * tstep; const char* cB = (const char*)g.Bt + (size_t)cur.pn * tstep;
    S.a_ready(cur);
    if constexpr (SP2) {
        PG8_STAGE(PG8_SB(0, 0), cB, voffB); PG8_STAGE(PG8_SB(0, 1), cB + hstep, voffB); PG8_STAGE(PG8_SA(0, 0), cA, voffA); PG8_STAGE(PG8_SA(0, 1), cA + hstep, voffA);
        if (wr == 1) PG8_BAR;
        PG8_WAIT_V(2); PG8_BAR;
        PG8_STAGE(PG8_SB(1, 0), cB + kstep, voffB); PG8_STAGE(PG8_SA(1, 0), cA + kstep, voffA); PG8_STAGE(PG8_SB(1, 1), cB + hstep + kstep, voffB);
        PG8_WAIT_V(6); PG8_BAR;
    } else {
        PG8_STAGE(PG8_SB(0, 0), cB, voffB); PG8_STAGE(PG8_SA(0, 0), cA, voffA); PG8_STAGE(PG8_SB(0, 1), cB + hstep, voffB); PG8_STAGE(PG8_SA(0, 1), cA + hstep, voffA);
        if (wr == 1) PG8_BAR;
        PG8_WAIT_V(4); PG8_BAR;
        PG8_STAGE(PG8_SB(1, 0), cB + kstep, voffB); PG8_STAGE(PG8_SA(1, 0), cA + kstep, voffA); PG8_STAGE(PG8_SB(1, 1), cB + hstep + kstep, voffB);
        PG8_WAIT_V(6); PG8_BAR;
    }
    for (;;) {
        const bool has_next = S.next(ui + 1, nxt);
        const char* nA = has_next ? (const char*)g.A + (size_t)nxt.pm * tstep : cA; const char* nB = has_next ? (const char*)g.Bt + (size_t)nxt.pn * tstep : cB;
        for (int t = 0; t < nt; t += 2) {
            const bool last = (t == nt - 2);
            const char* a1 = cA + (size_t)(t + 1) * kstep;
            const char* a2 = last ? nA : cA + (size_t)(t + 2) * kstep; const char* b2 = last ? nB : cB + (size_t)(t + 2) * kstep;
            const char* a3 = a2 + kstep; const char* b3 = b2 + kstep;
            if (last && has_next) S.a_ready(nxt);
            if constexpr (SP2) {
            PG8_LDB(B0, 0, 0); PG8_LDB(B1, 0, 1); PG8_SCHED; PG8_LDA(At, 0, 0); PG8_STAGE(PG8_SA(1, 1), a1 + hstep, voffA);
            PG8_WAIT_V(8); PG8_WAIT_L(0); PG8_BAR; PG8_MMA(0, 0, At, B0); PG8_MMA(0, 1, At, B1); PG8_BAR; PG8_SCHED;
            PG8_LDA(At, 0, 1); PG8_STAGE(PG8_SB(0, 0), b2, voffB); PG8_STAGE(PG8_SB(0, 1), b2 + hstep, voffB); PG8_STAGE(PG8_SA(0, 0), a2, voffA);
            PG8_WAIT_V(8); PG8_WAIT_L(0); PG8_BAR; PG8_MMA(1, 0, At, B0); PG8_MMA(1, 1, At, B1); PG8_BAR; PG8_SCHED;
            PG8_LDB(B0, 1, 0); PG8_LDB(B1, 1, 1); PG8_SCHED; PG8_LDA(At, 1, 0); PG8_STAGE(PG8_SA(0, 1), a2 + hstep, voffA);
            PG8_WAIT_V(8); PG8_WAIT_L(0); PG8_BAR; PG8_MMA(0, 0, At, B0); PG8_MMA(0, 1, At, B1); PG8_BAR; PG8_SCHED;
            PG8_LDA(At, 1, 1); PG8_STAGE(PG8_SB(1, 0), b3, voffB); PG8_STAGE(PG8_SB(1, 1), b3 + hstep, voffB); PG8_STAGE(PG8_SA(1, 0), a3, voffA);
            PG8_WAIT_V(8); PG8_WAIT_L(0); PG8_BAR; PG8_MMA(1, 0, At, B0); PG8_MMA(1, 1, At, B1); PG8_BAR; PG8_SCHED;
            } else {
            PG8_LDB(B0, 0, 0); PG8_SCHED; PG8_LDA(At, 0, 0); PG8_STAGE(PG8_SA(1, 1), a1 + hstep, voffA);
            PG8_WAIT_L(8); PG8_BAR; PG8_WAIT_L(0); PG8_MMA(0, 0, At, B0); PG8_BAR; PG8_SCHED;
            PG8_LDB(B1, 0, 1); PG8_STAGE(PG8_SB(0, 0), b2, voffB);
            PG8_BAR; PG8_WAIT_L(0); PG8_MMA(0, 1, At, B1); PG8_BAR;
            PG8_LDA(At, 0, 1); PG8_STAGE(PG8_SA(0, 0), a2, voffA);
            PG8_BAR; PG8_WAIT_L(0); PG8_MMA(1, 0, At, B0); PG8_BAR; PG8_SCHED;
            PG8_STAGE(PG8_SB(0, 1), b2 + hstep, voffB);
            PG8_WAIT_V(6); PG8_BAR; PG8_MMA(1, 1, At, B1); PG8_BAR;
            PG8_LDB(B0, 1, 0); PG8_SCHED; PG8_LDA(At, 1, 0); PG8_STAGE(PG8_SA(0, 1), a2 + hstep, voffA);
            PG8_WAIT_L(8); PG8_BAR; PG8_WAIT_L(0); PG8_MMA(0, 0, At, B0); PG8_BAR; PG8_SCHED;
            PG8_LDB(B1, 1, 1); PG8_STAGE(PG8_SB(1, 0), b3, voffB);
            PG8_BAR; PG8_WAIT_L(0); PG8_MMA(0, 1, At, B1); PG8_BAR;
            PG8_LDA(At, 1, 1); PG8_STAGE(PG8_SA(1, 0), a3, voffA);
            PG8_BAR; PG8_WAIT_L(0); PG8_MMA(1, 0, At, B0); PG8_BAR; PG8_SCHED;
            PG8_STAGE(PG8_SB(1, 1), b3 + hstep, voffB);
            PG8_WAIT_V(6); PG8_BAR; PG8_MMA(1, 1, At, B1); PG8_BAR;
            }
        }
        if constexpr (ALIGN_EPI) { if (wr == 0) PG8_BAR; }
        if constexpr (!Epi::AFTER_DRAIN) { E(acc, cur, wr, wc, fr, fq); S.done(cur); }
        if (!has_next) break;
#pragma unroll
        for (int a = 0; a < 2; ++a)
#pragma unroll
            for (int b = 0; b < 2; ++b)
#pragma unroll
                for (int m = 0; m < 4; ++m)
#pragma unroll
                    for (int n = 0; n < 2; ++n) acc[a][b][m][n] = (f32x4){0.f, 0.f, 0.f, 0.f};
        cur = nxt; cA = nA; cB = nB; ++ui;
        if constexpr (ALIGN_EPI) { if (wr == 1) PG8_BAR; }
    }
    PG8_WAIT_V(0);
    if constexpr (!ALIGN_EPI) { if (wr == 0) PG8_BAR; }
    PG8_BAR;
    if constexpr (Epi::AFTER_DRAIN) { E.fused(acc, cur, wr, wc, fr, fq, lds, wid, lane); S.done(cur); }
#undef PG8_SA
#undef PG8_SB
#undef PG8_STAGE
#undef PG8_LDA
#undef PG8_LDB
#undef PG8_MMA
#undef PG8_WAIT_V
#undef PG8_WAIT_L
#undef PG8_BAR
#undef PG8_SCHED
}
}
constexpr int SEQ = 2048, BATCH = 8, M = BATCH * SEQ, D = 1024, DFF = 4096, DIN = 2048, NCV = 3072, NH = 32, NIN = 5152, MODW = 6144;
constexpr float EPS = 1e-5f;
constexpr size_t MiB = 1u << 20;
constexpr size_t WS_MODP = 1 * MiB;
constexpr size_t WS_MOD = 2 * MiB + 512 * 1024;
constexpr size_t WS_WIN = 3 * MiB, WS_WOUT = 14 * MiB, WS_WUP0 = 18 * MiB, WS_WUP1 = 26 * MiB, WS_WDN0 = 34 * MiB, WS_WDN1 = 42 * MiB, WS_WSCIN = 50 * MiB, WS_WSCOUT = 56 * MiB;
constexpr size_t WS_DT = 58 * MiB, WS_SS = 60 * MiB, WS_H = 62 * MiB, WS_Z = 94 * MiB, WS_XBC = 158 * MiB, WS_END = 254 * MiB;
constexpr size_t WS_ACT = WS_Z, WS_PROJ = WS_Z, WS_YSC = WS_Z + 96 * MiB;
constexpr int LDS_BYTES = 147456;
constexpr size_t WS_SHB = 448 * 1024;

#define LAS __attribute__((address_space(3)))
typedef unsigned short bf16;
typedef unsigned u32x4 __attribute__((ext_vector_type(4)));
typedef unsigned u32x2 __attribute__((ext_vector_type(2)));
typedef float f32x4 __attribute__((ext_vector_type(4)));
typedef short bf16x8 __attribute__((ext_vector_type(8)));

__device__ __forceinline__ unsigned pk2(float lo, float hi) { unsigned r; asm("v_cvt_pk_bf16_f32 %0, %1, %2" : "=v"(r) : "v"(lo), "v"(hi)); return r; }
__device__ __forceinline__ float bflo(unsigned w) { return __uint_as_float(w << 16); }
__device__ __forceinline__ float bfhi(unsigned w) { return __uint_as_float(w & 0xffff0000u); }
__device__ __forceinline__ float bf1(bf16 v) { return __uint_as_float(((unsigned)v) << 16); }
__device__ __forceinline__ float fexp(float x) { return __builtin_amdgcn_exp2f(x * 1.4426950408889634f); }
__device__ __forceinline__ float silu_f(float v) { return v * __builtin_amdgcn_rcpf(1.0f + fexp(-v)); }
__device__ __forceinline__ float wave_sum(float v) {
#pragma unroll
    for (int o = 1; o < 64; o <<= 1) v += __shfl_xor(v, o);
    return v;
}
#define LDS_WAIT() asm volatile("s_waitcnt lgkmcnt(0)" ::: "memory")

struct Args { const float* in[20]; float* out; unsigned char* ws; };
enum { I_X = 0, I_C, I_ADAW, I_ADAB, I_MIXNW, I_MLPNW, I_UP, I_DOWN, I_SSDIN, I_SSDCW, I_SSDCB, I_DTB, I_ALOG, I_DSK, I_SSDNW, I_SSDOUT, I_SCIN, I_SCCW, I_SCOUT, I_FNW };

__device__ __forceinline__ void transpose_item(const float* W, int K, int N, bf16* WT, LAS float* scr, int item, int lane) {
    const int nblk = N / 32, kb = item / nblk, nb = item % nblk, k0 = 64 * kb, n0 = 32 * nb;
#pragma unroll 8
    for (int i = 0; i < 32; ++i) { const int kk = 2 * i + (lane >> 5); scr[kk * 33 + (lane & 31)] = W[(size_t)(k0 + kk) * N + n0 + (lane & 31)]; }
    LDS_WAIT(); asm volatile("" ::: "memory");
    const int c = lane & 7;
#pragma unroll
    for (int j = 0; j < 4; ++j) { const int n = (lane >> 3) + 8 * j; const LAS float* s = scr + (8 * c) * 33 + n;
        u32x4 o; o.x = pk2(s[0 * 33], s[1 * 33]); o.y = pk2(s[2 * 33], s[3 * 33]); o.z = pk2(s[4 * 33], s[5 * 33]); o.w = pk2(s[6 * 33], s[7 * 33]);
        *(u32x4*)(WT + (size_t)(n0 + n) * K + k0 + 8 * c) = o; }
    LDS_WAIT(); asm volatile("" ::: "memory");
}

__device__ __forceinline__ void p0_phase(const Args& a, LAS unsigned char* lds, int bid, int G, int tid, int lane, int wave) {
    unsigned char* ws = a.ws;
    LAS float* cond = (LAS float*)lds;
    LAS float* red = (LAS float*)(lds + 32768);
    const float* cin = a.in[I_C];
    for (int i = tid; i < 8192; i += 512) cond[i] = silu_f(cin[i]);
    __syncthreads();
    float* modp = (float*)(ws + WS_MODP);
    for (int it = bid; it < 768; it += G) {
        const int i = it / 384, r = it % 384, cb = r >> 2, ks = r & 3, n0 = cb * 64, k0 = ks * 256 + wave * 32;
        const float* wp = a.in[I_ADAW] + ((size_t)i * 1024 + k0) * MODW + n0 + lane;
        float acc[8];
#pragma unroll
        for (int b = 0; b < 8; ++b) acc[b] = 0.f;
#pragma unroll 8
        for (int kk = 0; kk < 32; ++kk) { const float wv = wp[(size_t)kk * MODW];
#pragma unroll
            for (int b = 0; b < 8; ++b) acc[b] += cond[b * 1024 + k0 + kk] * wv; }
#pragma unroll
        for (int b = 0; b < 8; ++b) red[(wave * 8 + b) * 64 + lane] = acc[b];
        __syncthreads();
        { const int b = tid >> 6; float s = 0.f;
#pragma unroll
          for (int w = 0; w < 8; ++w) s += red[(w * 8 + b) * 64 + lane];
          modp[(size_t)((ks * 2 + i) * 8 + b) * MODW + n0 + lane] = s; }
        __syncthreads();
    }
    LAS float* scr = (LAS float*)(lds + wave * 16384);
    const int gw = bid * 8 + wave, NGW = G * 8;
    constexpr int I0 = 16 * 161, I1 = 32 * 32, I2 = 16 * 128, I4 = 64 * 32, I6 = 16 * 96, I7 = 16 * 32;
    constexpr int NITEMS = I0 + I1 + 2 * I2 + 2 * I4 + I6 + I7;
    for (int it = gw; it < NITEMS; it += NGW) {
        int r = it;
        if (r < I0) { transpose_item(a.in[I_SSDIN], D, NIN, (bf16*)(ws + WS_WIN), scr, r, lane); continue; } r -= I0;
        if (r < I1) { transpose_item(a.in[I_SSDOUT], DIN, D, (bf16*)(ws + WS_WOUT), scr, r, lane); continue; } r -= I1;
        if (r < I2) { transpose_item(a.in[I_UP], D, DFF, (bf16*)(ws + WS_WUP0), scr, r, lane); continue; } r -= I2;
        if (r < I2) { transpose_item(a.in[I_UP] + (size_t)D * DFF, D, DFF, (bf16*)(ws + WS_WUP1), scr, r, lane); continue; } r -= I2;
        if (r < I4) { transpose_item(a.in[I_DOWN], DFF, D, (bf16*)(ws + WS_WDN0), scr, r, lane); continue; } r -= I4;
        if (r < I4) { transpose_item(a.in[I_DOWN] + (size_t)D * DFF, DFF, D, (bf16*)(ws + WS_WDN1), scr, r, lane); continue; } r -= I4;
        if (r < I6) { transpose_item(a.in[I_SCIN], D, 3 * D, (bf16*)(ws + WS_WSCIN), scr, r, lane); continue; } r -= I6;
        transpose_item(a.in[I_SCOUT], D, D, (bf16*)(ws + WS_WSCOUT), scr, r, lane);
    }
}

template <bool PART>
__device__ __forceinline__ void norm_phase(const Args& a, LAS unsigned char* lds, const float* src, const float* gw, int layer, int off_sh, int off_sc, bf16* dst,
                                           int bid, int G, int tid, int lane, int wave) {
    LAS float* Aw = (LAS float*)lds; LAS float* Sw = (LAS float*)(lds + 4096);
    const float* modp = (const float*)(a.ws + WS_MODP); const float* mod = (const float*)(a.ws + WS_MOD);
    for (int ck = bid; ck < 256; ck += G) {
        const int row0 = ck * 64, b = row0 >> 11;
        __syncthreads();
        for (int k = tid; k < 1024; k += 512) {
            float sc, sh;
            if (PART) { sc = a.in[I_ADAB][layer * MODW + off_sc + k]; sh = a.in[I_ADAB][layer * MODW + off_sh + k];
#pragma unroll
                for (int ks = 0; ks < 4; ++ks) { const float* p = modp + (size_t)((ks * 2 + layer) * 8 + b) * MODW; sc += p[off_sc + k]; sh += p[off_sh + k]; } }
            else { const float* p = mod + (size_t)(layer * 8 + b) * MODW; sc = p[off_sc + k]; sh = p[off_sh + k]; }
            Aw[k] = gw[k] * (1.0f + sc); Sw[k] = sh; }
        __syncthreads();
        for (int rr = wave; rr < 64; rr += 8) {
            const int row = row0 + rr;
            const f32x4* xr = (const f32x4*)(src + (size_t)row * D) + lane;
            f32x4 v[4]; float s = 0.f;
#pragma unroll
            for (int j = 0; j < 4; ++j) { v[j] = xr[64 * j]; s += (v[j].x * v[j].x + v[j].y * v[j].y) + (v[j].z * v[j].z + v[j].w * v[j].w); }
            const float rstd = __builtin_amdgcn_rsqf(wave_sum(s) * (1.f / D) + EPS);
            u32x2* o8 = (u32x2*)(dst + (size_t)row * D) + lane;
#pragma unroll
            for (int j = 0; j < 4; ++j) { const f32x4 aw = *(const LAS f32x4*)(Aw + 4 * lane + 256 * j), sw = *(const LAS f32x4*)(Sw + 4 * lane + 256 * j);
                const f32x4 o = v[j] * rstd * aw + sw; u32x2 w; w.x = pk2(o.x, o.y); w.y = pk2(o.z, o.w); o8[64 * j] = w; }
        }
    }
}
__device__ __forceinline__ void mod_finalize(const Args& a, int bid, int G, int tid) {
    const float* modp = (const float*)(a.ws + WS_MODP); float* mod = (float*)(a.ws + WS_MOD);
    for (int idx = bid * 512 + tid; idx < 2 * 8 * MODW; idx += G * 512) {
        const int i = idx / (8 * MODW), rem = idx % (8 * MODW), j = rem % MODW;
        float v = a.in[I_ADAB][i * MODW + j];
#pragma unroll
        for (int ks = 0; ks < 4; ++ks) v += modp[(size_t)(ks * 2 + i) * (8 * MODW) + rem];
        mod[idx] = v;
        const int mat = (i == 0) ? (j >= 3072 && j < 4096 ? 0 : -1) : (j < 1024 ? 1 : (j >= 3072 && j < 4096 ? 2 : -1));
        if (mat >= 0) ((bf16*)(a.ws + WS_SHB))[(size_t)(mat * 16 + rem / MODW) * D + (j & 1023)] = (bf16)(pk2(v, 0.f) & 0xffffu); }
    for (int idx = bid * 512 + tid; idx < 3 * 8 * D; idx += G * 512) ((bf16*)(a.ws + WS_SHB))[(size_t)((idx >> 13) * 16 + 8 + ((idx >> 10) & 7)) * D + (idx & 1023)] = 0;
}

__device__ __forceinline__ void dt_phase(const Args& a, int bid, int G, int lane, int wave) {
    const bf16* H = (const bf16*)(a.ws + WS_H); const bf16* WT = (const bf16*)(a.ws + WS_WIN); float* DT = (float*)(a.ws + WS_DT);
    const int fr = lane & 15, fq = lane >> 4;
    const f32x4 bias0 = *(const f32x4*)(a.in[I_DTB] + 4 * fq), bias1 = *(const f32x4*)(a.in[I_DTB] + 16 + 4 * fq);
    for (int it = bid * 8 + wave; it < M / 16; it += G * 8) {
        const int m0 = it * 16;
        const bf16* ap = H + (size_t)(m0 + fr) * D + 8 * fq;
        const bf16* bp0 = WT + (size_t)(5120 + fr) * D + 8 * fq; const bf16* bp1 = bp0 + (size_t)16 * D;
        f32x4 acc0 = {0.f, 0.f, 0.f, 0.f}, acc1 = {0.f, 0.f, 0.f, 0.f};
#pragma unroll 4
        for (int k0 = 0; k0 < D; k0 += 32) {
            const bf16x8 av = *(const bf16x8*)(ap + k0), b0 = *(const bf16x8*)(bp0 + k0), b1 = *(const bf16x8*)(bp1 + k0);
            acc0 = __builtin_amdgcn_mfma_f32_16x16x32_bf16(b0, av, acc0, 0, 0, 0);
            acc1 = __builtin_amdgcn_mfma_f32_16x16x32_bf16(b1, av, acc1, 0, 0, 0); }
        f32x4 o0, o1;
#pragma unroll
        for (int j = 0; j < 4; ++j) { const float x0 = acc0[j] + bias0[j], x1 = acc1[j] + bias1[j];
            o0[j] = fmaxf(x0, 0.f) + log1pf(expf(-fabsf(x0))); o1[j] = fmaxf(x1, 0.f) + log1pf(expf(-fabsf(x1))); }
        *(f32x4*)(DT + (size_t)(m0 + fr) * NH + 4 * fq) = o0; *(f32x4*)(DT + (size_t)(m0 + fr) * NH + 16 + 4 * fq) = o1;
    }
}
constexpr size_t WS_SW = 64 * 1024, WS_SSQ = WS_MODP;
__device__ __forceinline__ void sw_phase(const Args& a, int bid, int G, int lane, int wave) {
    float* SW = (float*)(a.ws + WS_SW); const bf16* SHB = (const bf16*)(a.ws + WS_SHB);
    const int fr = lane & 15, fq = lane >> 4;
    for (int it = bid * 8 + wave; it < 704; it += G * 8) {
        const int j = it < 256 ? 0 : (it < 448 ? 1 : 2), n0 = (it - (j == 0 ? 0 : (j == 1 ? 256 : 448))) * 16;
        const bf16* WT = (const bf16*)(a.ws + (j == 0 ? WS_WUP0 : (j == 1 ? WS_WSCIN : WS_WUP1)));
        const bf16* ap = SHB + (size_t)(j * 16 + fr) * D + 8 * fq; const bf16* bp = WT + (size_t)(n0 + fr) * D + 8 * fq;
        f32x4 acc = {0.f, 0.f, 0.f, 0.f};
#pragma unroll 8
        for (int k0 = 0; k0 < D; k0 += 32) acc = __builtin_amdgcn_mfma_f32_16x16x32_bf16(*(const bf16x8*)(ap + k0), *(const bf16x8*)(bp + k0), acc, 0, 0, 0);
        if (fq < 2) {
#pragma unroll
            for (int i = 0; i < 4; ++i) SW[(size_t)(j * 8 + 4 * fq + i) * 4096 + n0 + fr] = acc[i]; }
    }
}

__device__ __forceinline__ void bcconv_phase(const Args& a, int bid, int G, int lane, int wave) {
    const bf16* XBC = (const bf16*)(a.ws + WS_XBC); bf16* BC = (bf16*)(a.ws + WS_H);
    for (int it = bid * 8 + wave; it < 2048; it += G * 8) {
        const int seg = it >> 1, col = (it & 1) * 512 + lane * 8, row0 = seg * 16;
        float w[5][8];
#pragma unroll
        for (int k = 0; k < 5; ++k) { const float* wp = (k < 4 ? a.in[I_SSDCW] + k * NCV : a.in[I_SSDCB]) + 2048 + col; const f32x4 a0 = *(const f32x4*)wp, a1 = *(const f32x4*)(wp + 4);
            w[k][0] = a0.x; w[k][1] = a0.y; w[k][2] = a0.z; w[k][3] = a0.w; w[k][4] = a1.x; w[k][5] = a1.y; w[k][6] = a1.z; w[k][7] = a1.w; }
        u32x4 r3 = {0u, 0u, 0u, 0u}, r2 = r3, r1 = r3;
        const bf16* src = XBC + (size_t)row0 * NCV + 2048 + col;
        if ((row0 & (SEQ - 1)) != 0) { r3 = *(const u32x4*)(src - 3 * NCV); r2 = *(const u32x4*)(src - 2 * NCV); r1 = *(const u32x4*)(src - NCV); }
#pragma unroll 4
        for (int r = 0; r < 16; ++r) {
            const u32x4 r0 = *(const u32x4*)(src + (size_t)r * NCV);
            float y[8];
#pragma unroll
            for (int q = 0; q < 4; ++q) {
                y[2 * q] = silu_f(w[4][2 * q] + w[0][2 * q] * bflo(r3[q]) + w[1][2 * q] * bflo(r2[q]) + w[2][2 * q] * bflo(r1[q]) + w[3][2 * q] * bflo(r0[q]));
                y[2 * q + 1] = silu_f(w[4][2 * q + 1] + w[0][2 * q + 1] * bfhi(r3[q]) + w[1][2 * q + 1] * bfhi(r2[q]) + w[2][2 * q + 1] * bfhi(r1[q]) + w[3][2 * q + 1] * bfhi(r0[q])); }
            *(u32x4*)(BC + (size_t)(row0 + r) * D + col) = (u32x4){pk2(y[0], y[1]), pk2(y[2], y[3]), pk2(y[4], y[5]), pk2(y[6], y[7])};
            r3 = r2; r2 = r1; r1 = r0;
        }
    }
}

constexpr int RSB = 272;
constexpr int S_BM = 0, S_CM = 34816, S_BDT = 69632, S_XDT = 104448, S_ST = 121856, S_ACS = 139264, S_DTV = 139776, S_CW = 140288;
static_assert(S_CW + 5 * 320 * 4 <= LDS_BYTES, "SSD LDS map");
__device__ __forceinline__ float wave_scan_incl(float v, int lane) {
#pragma unroll
    for (int o = 1; o < 64; o <<= 1) { const float t = __shfl_up(v, o); if (lane >= o) v += t; }
    return v;
}
template <int NR>
__device__ __forceinline__ void conv_col(const u32x4 (&raw)[NR + 3], int j, const LAS float* cw, float (&o)[NR]) {
    float rf[NR + 3];
#pragma unroll
    for (int i = 0; i < NR + 3; ++i) { const unsigned w = raw[i][j >> 1]; rf[i] = (j & 1) ? bfhi(w) : bflo(w); }
    const float w0 = cw[j], w1 = cw[320 + j], w2 = cw[640 + j], w3 = cw[960 + j], bb = cw[1280 + j];
#pragma unroll
    for (int i = 0; i < NR; ++i) o[i] = silu_f(bb + w0 * rf[i] + w1 * rf[i + 1] + w2 * rf[i + 2] + w3 * rf[i + 3]);
}
__device__ __forceinline__ void ssd_phase(const Args& a, LAS unsigned char* lds, int bid, int G, int tid, int lane, int wave) {
    const bf16* XBC = (const bf16*)(a.ws + WS_XBC); bf16* Z = (bf16*)(a.ws + WS_Z); const float* DT = (const float*)(a.ws + WS_DT); float* SS = (float*)(a.ws + WS_SS);
    const int fr = lane & 15, fq = lane >> 4;
    LAS float* Acs = (LAS float*)(lds + S_ACS); LAS float* dtv = (LAS float*)(lds + S_DTV); LAS float* CW = (LAS float*)(lds + S_CW);
    for (int item = bid; item < 256; item += G) {
        const int xcd = item & 7, jj = item >> 3, pg = xcd * 4 + (jj >> 3), hh = jj & 7, b = pg >> 2, g = pg & 3, h = g * 8 + hh;
        const float A_h = -expf(a.in[I_ALOG][h]), D_h = a.in[I_DSK][h];
        __syncthreads();
        for (int i = tid; i < 5 * 320; i += 512) { const int k = i / 320, cl = i % 320;
            const int ch = cl < 64 ? h * 64 + cl : (cl < 192 ? 2048 + g * 128 + (cl - 64) : 2560 + g * 128 + (cl - 192));
            CW[i] = (k < 4) ? a.in[I_SSDCW][k * NCV + ch] : a.in[I_SSDCB][ch]; }
        for (int i = tid; i < 17408 / 4; i += 512) ((LAS unsigned*)(lds + S_ST))[i] = 0u;
        f32x4 sacc[4];
#pragma unroll
        for (int pb = 0; pb < 4; ++pb) sacc[pb] = (f32x4){0.f, 0.f, 0.f, 0.f};
        __syncthreads();
#define SBAR() do { asm volatile("s_waitcnt lgkmcnt(0)" ::: "memory"); __builtin_amdgcn_s_barrier(); asm volatile("" ::: "memory"); } while (0)
        const int cgpB = tid & 15, rsB = tid >> 4, cgpX = tid & 7, rsX = tid >> 3;
        const bf16* BCb = (const bf16*)(a.ws + WS_H);
        u32x4 rC[4], rB[4], rX[5]; float dA = 0.f, dB = 0.f;
#define LOAD_RAW(cc) do { const int t0n = b * SEQ + (cc) * 128; \
            const bf16* sB = BCb + (size_t)(t0n + 4 * rsB) * D + g * 128 + 8 * cgpB; \
            const bf16* sX = XBC + (ptrdiff_t)(t0n + 2 * rsX - 3) * NCV + h * 64 + 8 * cgpX; \
            _Pragma("unroll") for (int i = 0; i < 4; ++i) { rB[i] = *(const u32x4*)(sB + (size_t)i * D); rC[i] = *(const u32x4*)(sB + (size_t)i * D + 512); } \
            _Pragma("unroll") for (int i = 0; i < 5; ++i) { const bool ok = ((cc) > 0) || (2 * rsX - 3 + i >= 0); rX[i] = ok ? *(const u32x4*)(sX + (ptrdiff_t)i * NCV) : (u32x4){0u, 0u, 0u, 0u}; } \
            if (wave < 2) { dA = DT[(size_t)(t0n + lane) * NH + h]; dB = DT[(size_t)(t0n + 64 + lane) * NH + h]; } } while (0)
        LOAD_RAW(0);
        for (int c = 0; c < 16; ++c) {
            const int t0 = b * SEQ + c * 128;
            if (wave < 2) {
                const float s0 = wave_scan_incl(dA * A_h, lane);
                if (wave == 0) { Acs[lane] = s0; dtv[lane] = dA; }
                else { const float tot0 = __shfl(s0, 63); const float s1 = wave_scan_incl(dB * A_h, lane); Acs[64 + lane] = s1 + tot0; dtv[64 + lane] = dB; }
            }
#pragma unroll
            for (int i = 0; i < 4; ++i) *(LAS u32x4*)(lds + S_CM + (4 * rsB + i) * RSB + cgpB * 16) = rC[i];
            SBAR();
            {
                const float alast = Acs[127]; const f32x4 as4 = *(const LAS f32x4*)(Acs + 4 * rsB);
                float E[4];
#pragma unroll
                for (int i = 0; i < 4; ++i) E[i] = fexp(alast - as4[i]);
#pragma unroll
                for (int j2 = 0; j2 < 4; ++j2) { float oa[4], ob[4];
#pragma unroll
                    for (int i = 0; i < 4; ++i) { oa[i] = bflo(rB[i][j2]); ob[i] = bfhi(rB[i][j2]); }
                    *(LAS u32x2*)(lds + S_BDT + (8 * cgpB + 2 * j2) * RSB + rsB * 8) = (u32x2){pk2(oa[0] * E[0], oa[1] * E[1]), pk2(oa[2] * E[2], oa[3] * E[3])};
                    *(LAS u32x2*)(lds + S_BDT + (8 * cgpB + 2 * j2 + 1) * RSB + rsB * 8) = (u32x2){pk2(ob[0] * E[0], ob[1] * E[1]), pk2(ob[2] * E[2], ob[3] * E[3])}; }
#pragma unroll
                for (int i = 0; i < 4; ++i) *(LAS u32x4*)(lds + S_BM + (4 * rsB + i) * RSB + cgpB * 16) = rB[i];
            }
            {
                const float d0 = dtv[2 * rsX], d1 = dtv[2 * rsX + 1];
#pragma unroll
                for (int j = 0; j < 8; ++j) { float o[2]; conv_col<2>(rX, j, CW + 8 * cgpX, o);
                    *(LAS unsigned*)(lds + S_XDT + (8 * cgpX + j) * RSB + rsX * 4) = pk2(o[0] * d0, o[1] * d1); }
            }
            if (c < 15) LOAD_RAW(c + 1);
            SBAR();
            bf16x8 Cf[4];
#pragma unroll
            for (int kk = 0; kk < 4; ++kk) Cf[kk] = *(const LAS bf16x8*)(lds + S_CM + (16 * wave + fr) * RSB + (32 * kk + 8 * fq) * 2);
            unsigned Mw[4][4];
#pragma unroll
            for (int kb = 0; kb < 4; ++kb)
#pragma unroll
                for (int e = 0; e < 4; ++e) Mw[kb][e] = 0u;
            const float acs_l = Acs[16 * wave + fr]; const int lidx = 16 * wave + fr;
#pragma unroll
            for (int sb = 0; sb < 8; ++sb) {
                if (sb <= wave) {
                    f32x4 s = {0.f, 0.f, 0.f, 0.f};
#pragma unroll
                    for (int kk = 0; kk < 4; ++kk) { const bf16x8 af = *(const LAS bf16x8*)(lds + S_BM + (16 * sb + fr) * RSB + (32 * kk + 8 * fq) * 2);
                        s = __builtin_amdgcn_mfma_f32_16x16x32_bf16(af, Cf[kk], s, 0, 0, 0); }
                    const f32x4 as4 = *(const LAS f32x4*)(Acs + 16 * sb + 4 * fq);
                    float v[4];
#pragma unroll
                    for (int i = 0; i < 4; ++i) { const int sidx = 16 * sb + 4 * fq + i; const float e = fexp(fminf(acs_l - as4[i], 0.f)); v[i] = (sidx <= lidx) ? s[i] * e : 0.f; }
                    Mw[sb >> 1][(sb & 1) * 2 + 0] = pk2(v[0], v[1]); Mw[sb >> 1][(sb & 1) * 2 + 1] = pk2(v[2], v[3]);
                }
            }
            f32x4 yd[4];
#pragma unroll
            for (int pb = 0; pb < 4; ++pb) yd[pb] = (f32x4){0.f, 0.f, 0.f, 0.f};
            if (c > 0) {
#pragma unroll
                for (int kk = 0; kk < 4; ++kk)
#pragma unroll
                    for (int pb = 0; pb < 4; ++pb) { const bf16x8 sf = *(const LAS bf16x8*)(lds + S_ST + (16 * pb + fr) * RSB + (32 * kk + 8 * fq) * 2);
                        yd[pb] = __builtin_amdgcn_mfma_f32_16x16x32_bf16(Cf[kk], sf, yd[pb], 0, 0, 0); }
                const f32x4 al4 = *(const LAS f32x4*)(Acs + 16 * wave + 4 * fq);
                f32x4 ea4;
#pragma unroll
                for (int i = 0; i < 4; ++i) ea4[i] = fexp(al4[i]);
#pragma unroll
                for (int pb = 0; pb < 4; ++pb) yd[pb] = yd[pb] * ea4;
            }
            bf16 zr[4][4];
#pragma unroll
            for (int pb = 0; pb < 4; ++pb)
#pragma unroll
                for (int i = 0; i < 4; ++i) zr[pb][i] = Z[(size_t)(t0 + 16 * wave + 4 * fq + i) * DIN + h * 64 + 16 * pb + fr];
#pragma unroll
            for (int kb = 0; kb < 4; ++kb) {
                if (2 * kb <= wave) {
                    const u32x4 mw = {Mw[kb][0], Mw[kb][1], Mw[kb][2], Mw[kb][3]}; const bf16x8 mf = __builtin_bit_cast(bf16x8, mw);
#pragma unroll
                    for (int pb = 0; pb < 4; ++pb) { const u32x2 lo = *(const LAS u32x2*)(lds + S_XDT + (16 * pb + fr) * RSB + (32 * kb + 4 * fq) * 2);
                        const u32x2 hi = *(const LAS u32x2*)(lds + S_XDT + (16 * pb + fr) * RSB + (32 * kb + 16 + 4 * fq) * 2);
                        const u32x4 xw = {lo.x, lo.y, hi.x, hi.y};
                        yd[pb] = __builtin_amdgcn_mfma_f32_16x16x32_bf16(mf, __builtin_bit_cast(bf16x8, xw), yd[pb], 0, 0, 0); }
                }
            }
            {
                const f32x4 dt4 = *(const LAS f32x4*)(dtv + 16 * wave + 4 * fq);
                float rdt[4], ssq[4];
#pragma unroll
                for (int i = 0; i < 4; ++i) { rdt[i] = __builtin_amdgcn_rcpf(dt4[i]); ssq[i] = 0.f; }
#pragma unroll
                for (int pb = 0; pb < 4; ++pb) {
                    const u32x2 xd = *(const LAS u32x2*)(lds + S_XDT + (16 * pb + fr) * RSB + (16 * wave + 4 * fq) * 2);
                    const float xv[4] = {bflo(xd.x), bfhi(xd.x), bflo(xd.y), bfhi(xd.y)};
#pragma unroll
                    for (int i = 0; i < 4; ++i) {
                        const float z = bf1(zr[pb][i]);
                        const float y = yd[pb][i] + D_h * xv[i] * rdt[i];
                        const float yz = y * silu_f(z);
                        Z[(size_t)(t0 + 16 * wave + 4 * fq + i) * DIN + h * 64 + 16 * pb + fr] = (bf16)(pk2(yz, 0.f) & 0xffffu); ssq[i] += yz * yz;
                    }
                }
#pragma unroll
                for (int i = 0; i < 4; ++i) { float s = ssq[i]; s += __shfl_xor(s, 1); s += __shfl_xor(s, 2); s += __shfl_xor(s, 4); s += __shfl_xor(s, 8);
                    if (fr == 0) SS[(size_t)(t0 + 16 * wave + 4 * fq + i) * NH + h] = s; }
            }
            if (c < 15) {
                const float dec = fexp(Acs[127]);
#pragma unroll
                for (int pb = 0; pb < 4; ++pb) sacc[pb] = sacc[pb] * dec;
#pragma unroll
                for (int ks = 0; ks < 4; ++ks) { const bf16x8 bfr = *(const LAS bf16x8*)(lds + S_BDT + (16 * wave + fr) * RSB + (32 * ks + 8 * fq) * 2);
#pragma unroll
                    for (int pb = 0; pb < 4; ++pb) { const bf16x8 xf = *(const LAS bf16x8*)(lds + S_XDT + (16 * pb + fr) * RSB + (32 * ks + 8 * fq) * 2);
                        sacc[pb] = __builtin_amdgcn_mfma_f32_16x16x32_bf16(bfr, xf, sacc[pb], 0, 0, 0); } }
            }
            SBAR();
            if (c < 15) {
#pragma unroll
                for (int pb = 0; pb < 4; ++pb) *(LAS u32x2*)(lds + S_ST + (16 * pb + fr) * RSB + (16 * wave + 4 * fq) * 2) = (u32x2){pk2(sacc[pb][0], sacc[pb][1]), pk2(sacc[pb][2], sacc[pb][3])};
            }
        }
#undef LOAD_RAW
        asm volatile("s_waitcnt vmcnt(0) lgkmcnt(0)" ::: "memory");
    }
}

__device__ __forceinline__ void gnorm_phase(const Args& a, int bid, int G, int lane, int wave) {
    bf16* YZ = (bf16*)(a.ws + WS_Z); const float* SS = (const float*)(a.ws + WS_SS); const float* nw = a.in[I_SSDNW];
    for (int row = bid * 8 + wave; row < M; row += G * 8) {
#pragma unroll
        for (int g = 0; g < 4; ++g) {
            u32x4* p = (u32x4*)(YZ + (size_t)row * DIN + g * 512 + lane * 8);
            const u32x4 v = *p;
            float s = SS[(size_t)row * NH + g * 8 + (lane & 7)]; s += __shfl_xor(s, 1); s += __shfl_xor(s, 2); s += __shfl_xor(s, 4);
            const float rs = __builtin_amdgcn_rsqf(s * (1.0f / 512.0f) + EPS);
            const f32x4 w0 = *(const f32x4*)(nw + g * 512 + lane * 8), w1 = *(const f32x4*)(nw + g * 512 + lane * 8 + 4);
            u32x4 o; o.x = pk2(bflo(v.x) * rs * w0.x, bfhi(v.x) * rs * w0.y); o.y = pk2(bflo(v.y) * rs * w0.z, bfhi(v.y) * rs * w0.w);
            o.z = pk2(bflo(v.z) * rs * w1.x, bfhi(v.z) * rs * w1.y); o.w = pk2(bflo(v.w) * rs * w1.z, bfhi(v.w) * rs * w1.w);
            *p = o;
        }
    }
}

__device__ __forceinline__ void sconv_phase(const Args& a, int bid, int G, int lane, int wave) {
    const bf16* P = (const bf16*)(a.ws + WS_PROJ); bf16* Y = (bf16*)(a.ws + WS_YSC); const float* cw = a.in[I_SCCW];
    for (int it = bid * 8 + wave; it < 2048; it += G * 8) {
        const int seg = it >> 1, col = (it & 1) * 512 + lane * 8, row0 = seg * 16;
        float w[3][8];
#pragma unroll
        for (int k = 0; k < 3; ++k) { const f32x4 a0 = *(const f32x4*)(cw + k * D + col), a1 = *(const f32x4*)(cw + k * D + col + 4);
            w[k][0] = a0.x; w[k][1] = a0.y; w[k][2] = a0.z; w[k][3] = a0.w; w[k][4] = a1.x; w[k][5] = a1.y; w[k][6] = a1.z; w[k][7] = a1.w; }
        float u2[8], u1[8];
#pragma unroll
        for (int j = 0; j < 8; ++j) { u2[j] = 0.f; u1[j] = 0.f; }
        if ((row0 & (SEQ - 1)) != 0) {
            const u32x4 c2 = *(const u32x4*)(P + (size_t)(row0 - 2) * NCV + D + col), x2 = *(const u32x4*)(P + (size_t)(row0 - 2) * NCV + 2 * D + col);
            const u32x4 c1 = *(const u32x4*)(P + (size_t)(row0 - 1) * NCV + D + col), x1 = *(const u32x4*)(P + (size_t)(row0 - 1) * NCV + 2 * D + col);
#pragma unroll
            for (int q = 0; q < 4; ++q) { u2[2 * q] = bflo(c2[q]) * bflo(x2[q]); u2[2 * q + 1] = bfhi(c2[q]) * bfhi(x2[q]); u1[2 * q] = bflo(c1[q]) * bflo(x1[q]); u1[2 * q + 1] = bfhi(c1[q]) * bfhi(x1[q]); }
        }
#pragma unroll 4
        for (int r = 0; r < 16; ++r) {
            const bf16* rp = P + (size_t)(row0 + r) * NCV + col;
            const u32x4 bg = *(const u32x4*)rp, cv = *(const u32x4*)(rp + D), xv = *(const u32x4*)(rp + 2 * D);
            float u0[8], y[8];
#pragma unroll
            for (int q = 0; q < 4; ++q) { u0[2 * q] = bflo(cv[q]) * bflo(xv[q]); u0[2 * q + 1] = bfhi(cv[q]) * bfhi(xv[q]); }
#pragma unroll
            for (int j = 0; j < 8; ++j) { const float bgv = (j & 1) ? bfhi(bg[j >> 1]) : bflo(bg[j >> 1]); y[j] = bgv * (w[0][j] * u2[j] + w[1][j] * u1[j] + w[2][j] * u0[j]); u2[j] = u1[j]; u1[j] = u0[j]; }
            *(u32x4*)(Y + (size_t)(row0 + r) * D + col) = (u32x4){pk2(y[0], y[1]), pk2(y[2], y[3]), pk2(y[4], y[5]), pk2(y[6], y[7])};
        }
    }
}

__device__ __forceinline__ void fnorm_phase(const Args& a, int bid, int G, int lane, int wave) {
    const float* gw = a.in[I_FNW];
    for (int row = bid * 8 + wave; row < M; row += G * 8) {
        f32x4* xr = (f32x4*)(a.out + (size_t)row * D) + lane;
        f32x4 v[4]; float s = 0.f;
#pragma unroll
        for (int j = 0; j < 4; ++j) { v[j] = xr[64 * j]; s += (v[j].x * v[j].x + v[j].y * v[j].y) + (v[j].z * v[j].z + v[j].w * v[j].w); }
        const float rstd = __builtin_amdgcn_rsqf(wave_sum(s) * (1.f / D) + EPS);
#pragma unroll
        for (int j = 0; j < 4; ++j) { const f32x4 w = *(const f32x4*)(gw + 4 * lane + 256 * j); xr[64 * j] = v[j] * rstd * w; }
    }
}


#define XB_TMO      128
#define XB_XCNT(j)  (256  + 64 * (j))
#define XB_XSUB(j)  (1280 + 64 * (j))
#define XB_XGEN(j)  (2304 + 64 * (j))
#define XB_TOP      3328
#define XB_TOPGEN   3392
#define XCD_BAR_WORDS 3456
#define XB_SPIN_CAP (1u << 18)

__device__ __forceinline__ unsigned xb_ld(unsigned* p)              { return __hip_atomic_load(p, __ATOMIC_RELAXED, __HIP_MEMORY_SCOPE_AGENT); }
__device__ __forceinline__ unsigned xb_add(unsigned* p, unsigned v) { return __hip_atomic_fetch_add(p, v, __ATOMIC_RELAXED, __HIP_MEMORY_SCOPE_AGENT); }
__device__ __forceinline__ unsigned xb_xcc_id() { return (unsigned)__builtin_amdgcn_s_getreg((3 << 11) | 20) & 0xFu; }
#define XB_SPIN(cond, bar) do { unsigned _sp = 0; while (cond) { __builtin_amdgcn_s_sleep(1); \
    if ((++_sp & 255u) == 0u) { if (xb_ld(&(bar)[XB_TMO])) break; if (_sp > XB_SPIN_CAP) { atomicAdd(&(bar)[XB_TMO], 1u); break; } } } } while (0)

struct XcdBarrier {
    unsigned* bar; unsigned x;
    volatile LAS unsigned* st;
};

__device__ __forceinline__ XcdBarrier xcd_barrier_post(unsigned* bar, volatile LAS unsigned* st) {
    XcdBarrier b; b.bar = bar; b.x = xb_xcc_id(); b.st = st;
    if (threadIdx.x == 0) (void)xb_add(&bar[XB_XCNT(b.x)], 1u);
    return b;
}
__device__ __forceinline__ void xcd_barrier_complete(unsigned* bar, unsigned x, unsigned& nloc, unsigned& nx) {
    const unsigned G = gridDim.x * gridDim.y * gridDim.z;
    unsigned sum, cnt, mine, sp = 0u;
    for (;;) {
        sum = 0u; cnt = 0u; mine = 0u;
#pragma unroll
        for (unsigned j = 0; j < 16; ++j) { const unsigned c = xb_ld(&bar[XB_XCNT(j)]); sum += c; cnt += (c > 0u) ? 1u : 0u; mine = (j == x) ? c : mine; }
        if (sum == G) break;
        __builtin_amdgcn_s_sleep(1);
        if ((++sp & 255u) == 0u) { if (xb_ld(&bar[XB_TMO])) break; if (sp > XB_SPIN_CAP) { atomicAdd(&bar[XB_TMO], 1u); break; } }
    }
    nloc = mine > 0u ? mine : 1u; nx = cnt > 0u ? cnt : 1u;
}

__device__ __forceinline__ void xcd_barrier(const XcdBarrier& b) {
    asm volatile("s_waitcnt vmcnt(0)" ::: "memory");
    __syncthreads();
    if (threadIdx.x == 0) {
        unsigned* bar = b.bar;
        __builtin_amdgcn_s_waitcnt(0);
        unsigned nloc = b.st[0], nx = b.st[1];
        if (nloc == 0u) { xcd_barrier_complete(bar, b.x, nloc, nx); b.st[0] = nloc; b.st[1] = nx; }
        const unsigned old = xb_add(&bar[XB_XSUB(b.x)], 1u);
        const unsigned gen = old / nloc;
        if (old + 1u == (gen + 1u) * nloc) {
            __builtin_amdgcn_fence(__ATOMIC_RELEASE, "agent");
            asm volatile("s_waitcnt vmcnt(0)" ::: "memory");
            const unsigned og = xb_add(&bar[XB_TOP], 1u);
            const unsigned tg = og / nx;
            if (og + 1u == (tg + 1u) * nx) xb_add(&bar[XB_TOPGEN], 1u);
            else XB_SPIN(xb_ld(&bar[XB_TOPGEN]) == tg, bar);
            __builtin_amdgcn_fence(__ATOMIC_ACQUIRE, "agent");
            xb_add(&bar[XB_XGEN(b.x)], 1u);
            asm volatile("s_waitcnt vmcnt(0)" ::: "memory");
        } else {
            XB_SPIN(xb_ld(&bar[XB_XGEN(b.x)]) == gen, bar);
            __builtin_amdgcn_fence(__ATOMIC_ACQUIRE, "agent");
            asm volatile("s_waitcnt vmcnt(0)" ::: "memory");
        }
    }
    __syncthreads();
}

#ifndef AMP_MASK
#define AMP_MASK 0
#endif
#ifndef AMP_K
#define AMP_K 1
#endif
#ifndef SYNC_REP
#define SYNC_REP 1
#endif
#define PH(id, ...) do { if ((AMP_MASK >> (id)) & 1) { const unsigned long long _t0 = __builtin_amdgcn_s_memrealtime(); __VA_ARGS__; __syncthreads(); \
    const unsigned long long _el = __builtin_amdgcn_s_memrealtime() - _t0; while (__builtin_amdgcn_s_memrealtime() - _t0 < _el * (1 + AMP_K)) __builtin_amdgcn_s_sleep(8); } else { __VA_ARGS__; } } while (0)
__device__ __forceinline__ void gsync_cg(cg::grid_group& grid) {
    asm volatile("s_waitcnt vmcnt(0) lgkmcnt(0)" ::: "memory");
    __threadfence();
    grid.sync();
    __threadfence();
}
#define gsync(grid) xcd_barrier(xbar)
template <class Epi>
__device__ __forceinline__ void run_gemm(LAS unsigned char* lds, const bf16* A, const bf16* Bt, int N, int K, const Epi& E, int G, int bid) {
    pg8::Gemm g{A, Bt, M, N, K}; pg8::StaticOrder S; S.init(M, N, G, bid);
    pg8::gemm_phase<Epi, pg8::StaticOrder, true, true>(lds, g, S, E);
}

__global__ void __launch_bounds__(512, 2) mk_fwd(Args a) {
    extern __shared__ __attribute__((aligned(16))) unsigned char lds_raw[];
    LAS unsigned char* lds = (LAS unsigned char*)lds_raw;
    cg::grid_group grid = cg::this_grid();
    const int tid = threadIdx.x, lane = tid & 63, wave = __builtin_amdgcn_readfirstlane(tid >> 6), bid = blockIdx.x, G = gridDim.x;
    unsigned char* ws = a.ws;
    bf16* H = (bf16*)(ws + WS_H);
    const float* MOD = (const float*)(ws + WS_MOD);

    if (bid == 0) for (int i = tid; i < XCD_BAR_WORDS; i += 512) ((unsigned*)ws)[i] = 0u;
    if (tid < 16) ((volatile LAS unsigned*)(lds + LDS_BYTES - 64))[tid] = 0u;
    asm volatile("s_waitcnt vmcnt(0) lgkmcnt(0)" ::: "memory");
    grid.sync();
    XcdBarrier xbar = xcd_barrier_post((unsigned*)ws, (volatile LAS unsigned*)(lds + LDS_BYTES - 64));
    PH(0, p0_phase(a, lds, bid, G, tid, lane, wave));
    gsync(grid);
    mod_finalize(a, bid, G, tid);
    PH(1, norm_phase<true>(a, lds, a.in[I_X], a.in[I_MIXNW], 0, 0, 1024, H, bid, G, tid, lane, wave));
    gsync(grid);
    { pg8::EpiBf16S<0> E{(bf16*)(ws + WS_Z), DIN, (bf16*)(ws + WS_XBC), NCV, DIN};
      PH(2, run_gemm(lds, H, (const bf16*)(ws + WS_WIN), 5120, D, E, G, bid)); }
    PH(4, dt_phase(a, bid, G, lane, wave));
    PH(4, sw_phase(a, bid, G, lane, wave));
    gsync(grid);
    PH(1, bcconv_phase(a, bid, G, lane, wave));
    gsync(grid);
    PH(3, ssd_phase(a, lds, bid, G, tid, lane, wave));
    gsync(grid);
    PH(1, gnorm_phase(a, bid, G, lane, wave));
    gsync(grid);
    float* SSQ = (float*)(ws + WS_SSQ); const float* SW = (const float*)(ws + WS_SW);
    { pg8::EpiRes2 E{a.in[I_X], a.out, MOD + 2048, H, a.in[I_MLPNW], MOD + 4096, SSQ};
      PH(2, run_gemm(lds, (const bf16*)(ws + WS_Z), (const bf16*)(ws + WS_WOUT), D, DIN, E, G, bid)); }
    gsync(grid);
    { pg8::EpiBf16N<2> E{(bf16*)(ws + WS_ACT), DFF, SW, SSQ};
      PH(2, run_gemm(lds, H, (const bf16*)(ws + WS_WUP0), DFF, D, E, G, bid)); }
    gsync(grid);
    { pg8::EpiRes2 E{a.out, a.out, MOD + 5120, H, a.in[I_MIXNW] + D, MOD + 8 * MODW + 1024, SSQ};
      PH(2, run_gemm(lds, (const bf16*)(ws + WS_ACT), (const bf16*)(ws + WS_WDN0), D, DFF, E, G, bid)); }
    gsync(grid);
    { pg8::EpiBf16N<0> E{(bf16*)(ws + WS_PROJ), NCV, SW + 8 * 4096, SSQ};
      PH(2, run_gemm(lds, H, (const bf16*)(ws + WS_WSCIN), NCV, D, E, G, bid)); }
    gsync(grid);
    PH(1, sconv_phase(a, bid, G, lane, wave));
    gsync(grid);
    { pg8::EpiRes2 E{a.out, a.out, MOD + 8 * MODW + 2048, H, a.in[I_MLPNW] + D, MOD + 8 * MODW + 4096, SSQ};
      PH(2, run_gemm(lds, (const bf16*)(ws + WS_YSC), (const bf16*)(ws + WS_WSCOUT), D, D, E, G, bid)); }
    gsync(grid);
    { pg8::EpiBf16N<2> E{(bf16*)(ws + WS_ACT), DFF, SW + 16 * 4096, SSQ};
      PH(2, run_gemm(lds, H, (const bf16*)(ws + WS_WUP1), DFF, D, E, G, bid)); }
    gsync(grid);
    { pg8::EpiRes E{a.out, a.out, MOD + 8 * MODW + 5120};
      PH(2, run_gemm(lds, (const bf16*)(ws + WS_ACT), (const bf16*)(ws + WS_WDN1), D, DFF, E, G, bid)); }
    gsync(grid);
    PH(1, fnorm_phase(a, bid, G, lane, wave));
}

extern "C" void kernel_launch(void* const* d_in, const int* in_sizes, int n_in, void* d_out, int out_size, void* d_ws, size_t ws_size, hipStream_t stream) {
    static int grid = 0;
    if (grid == 0) {
        if (n_in != 20 || in_sizes[0] != M * D || out_size != M * D || ws_size < WS_END) { fprintf(stderr, "kernel_launch: unexpected shapes (n_in %d, in0 %d, out %d, ws %zu)\n", n_in, n_in > 0 ? in_sizes[0] : -1, out_size, ws_size); grid = -1; return; }
        int dev = 0, cus = 0, per_cu = 0;
        hipGetDevice(&dev); hipDeviceGetAttribute(&cus, hipDeviceAttributeMultiprocessorCount, dev);
        if (hipFuncSetAttribute((const void*)mk_fwd, hipFuncAttributeMaxDynamicSharedMemorySize, LDS_BYTES) != hipSuccess) { fprintf(stderr, "kernel_launch: hipFuncSetAttribute failed\n"); grid = -1; return; }
        if (hipOccupancyMaxActiveBlocksPerMultiprocessor(&per_cu, (const void*)mk_fwd, 512, LDS_BYTES) != hipSuccess || per_cu < 1) { fprintf(stderr, "kernel_launch: occupancy query says %d blocks per CU\n", per_cu); (void)hipGetLastError(); per_cu = 1; }
        grid = cus;
        if (grid <= 0) { grid = -1; return; }
    }
    if (grid < 0) return;
    Args a{};
    for (int i = 0; i < 20; ++i) a.in[i] = (const float*)d_in[i];
    a.out = (float*)d_out; a.ws = (unsigned char*)d_ws;
    void* args[] = {&a};
    hipError_t e = hipLaunchCooperativeKernel((const void*)mk_fwd, dim3(grid), dim3(512), args, LDS_BYTES, stream);
    if (e != hipSuccess) fprintf(stderr, "cooperative launch failed: %s (grid %d)\n", hipGetErrorString(e), grid);
}
```
